# Optimizing an MI355X kernel written in HIP

```python
import jax, jax.numpy as jnp
from jax import lax
import numpy as np

D_MODEL = 1024
BATCH = 8
SEQ = 2048
DEPTH = 1
DEC_BATCH = 128
DEC_SEQ = 1
PAST_LEN = 16384
PAGE_SIZE = 128

MLSTM_HEADS = 4
HEAD_DIM = 128
MLSTM_W = MLSTM_HEADS * HEAD_DIM
CONV_GROUPS = 4
CONV_CH = D_MODEL - MLSTM_W
CONV_WIDTH = 3
D_FF = 4 * D_MODEL
PLE_DIM = 256
CHUNK = 64
EPS = 1e-6
M_INIT = -1e30
N_IN = 4 * MLSTM_W + 2 * MLSTM_HEADS + 3 * CONV_CH

kernel_name = 'hymba_mlstm_shortconv_decoder_step'


def rmsnorm(x, g):
    xf = x.astype(jnp.float32)
    y = xf * lax.rsqrt(jnp.mean(xf * xf, axis=-1, keepdims=True) + EPS)
    return (y * g.astype(jnp.float32)).astype(x.dtype)


def mlstm_chunkwise(q, k, v, ig, lf, C0, n0, m0):
    B, S, H, Dk = q.shape
    Dv = v.shape[-1]
    L = CHUNK if S % CHUNK == 0 else S
    nc = S // L

    def to_chunks(a):
        return jnp.moveaxis(a.reshape((B, nc, L) + a.shape[2:]), 1, 0)

    causal = jnp.tril(jnp.ones((L, L), dtype=bool))

    def step(carry, xs):
        C, n, m = carry
        qc, kc, vc, ic, fc = xs
        b = jnp.cumsum(fc, axis=1)
        dlog = b[:, :, None, :] - b[:, None, :, :] + ic[:, None, :, :]
        dlog = jnp.where(causal[None, :, :, None], dlog, -jnp.inf)
        m_inter = b + m[:, None, :]
        m_t = jnp.maximum(m_inter, jnp.max(dlog, axis=2))
        dmat = jnp.exp(dlog - m_t[:, :, None, :])
        scores = jnp.einsum('bthd,bshd->btsh', qc, kc) * dmat
        decay = jnp.exp(m_inter - m_t)
        num = (jnp.einsum('btsh,bshv->bthv', scores, vc)
               + decay[..., None] * jnp.einsum('bthk,bhkv->bthv', qc, C))
        den = jnp.sum(scores, axis=2) + decay * jnp.einsum('bthk,bhk->bth', qc, n)
        h = num / jnp.maximum(jnp.abs(den), jnp.exp(-m_t))[..., None]
        m_new = m_t[:, -1]
        w = jnp.exp(b[:, -1:, :] - b + ic - m_new[:, None, :])
        cdec = jnp.exp(b[:, -1] + m - m_new)
        C_new = cdec[..., None, None] * C + jnp.einsum('bsh,bshk,bshv->bhkv', w, kc, vc)
        n_new = cdec[..., None] * n + jnp.einsum('bsh,bshk->bhk', w, kc)
        return (C_new, n_new, m_new), h

    xs = (to_chunks(q), to_chunks(k), to_chunks(v), to_chunks(ig), to_chunks(lf))
    (C, n, m), hs = lax.scan(step, (C0, n0, m0), xs)
    h = jnp.moveaxis(hs, 0, 1).reshape(B, S, H, Dv)
    return h, C, n, m


def layer(x, p, conv_buf, C0, n0, m0, norm_mix, w_in, b_gate_i, b_gate_f, mh_norm,
          conv_w, w_out, norm_mlp, w_up, w_down, norm_ple, w_ple_gate, w_ple_proj):
    B, S, _ = x.shape
    f32 = jnp.float32
    h = rmsnorm(x, norm_mix)
    z = h @ w_in
    sizes = [MLSTM_W, MLSTM_W, MLSTM_W, MLSTM_W, MLSTM_HEADS, MLSTM_HEADS, CONV_CH, CONV_CH, CONV_CH]
    offs = []
    acc = 0
    for s in sizes[:-1]:
        acc += s
        offs.append(acc)
    q, k, v, og, ig, fg, gb, gc, u = jnp.split(z, offs, axis=-1)
    q = q.astype(f32).reshape(B, S, MLSTM_HEADS, HEAD_DIM) * (HEAD_DIM ** -0.5)
    k = k.astype(f32).reshape(B, S, MLSTM_HEADS, HEAD_DIM)
    v = v.astype(f32).reshape(B, S, MLSTM_HEADS, HEAD_DIM)
    ig = ig.astype(f32) + b_gate_i.astype(f32)
    lf = jax.nn.log_sigmoid(fg.astype(f32) + b_gate_f.astype(f32))
    hm, C, n, m = mlstm_chunkwise(q, k, v, ig, lf, C0.astype(f32), n0.astype(f32), m0.astype(f32))
    hm = hm * lax.rsqrt(jnp.mean(hm * hm, axis=-1, keepdims=True) + EPS)
    hm = hm * mh_norm.astype(f32).reshape(MLSTM_HEADS, HEAD_DIM)
    hm = hm.reshape(B, S, MLSTM_W) * jax.nn.sigmoid(og.astype(f32))
    cu = gc * u
    full = jnp.concatenate([conv_buf.astype(cu.dtype), cu], axis=1)
    yc = conv_w[0] * full[:, 0:S]
    for j in range(1, CONV_WIDTH):
        yc = yc + conv_w[j] * full[:, j:j + S]
    new_buf = full[:, S:]
    yc = gb * yc
    mix = jnp.concatenate([hm.astype(x.dtype), yc.astype(x.dtype)], axis=-1) @ w_out
    x = x + mix
    hf = jax.nn.relu(rmsnorm(x, norm_mlp) @ w_up)
    x = x + (hf * hf) @ w_down
    gate = jax.nn.sigmoid((rmsnorm(x, norm_ple) @ w_ple_gate).astype(f32))
    x = x + (gate * (p @ w_ple_proj).astype(f32)).astype(x.dtype)
    return x, new_buf, C, n, m


def setup_inputs(seed: int = 0) -> dict:
    key = jax.random.key(seed)
    ks = jax.random.split(key, 24)
    nrm = jax.random.normal
    f32 = jnp.float32
    d = {}
    d['x_prompt'] = nrm(ks[0], (BATCH, SEQ, D_MODEL), f32)
    d['x_sample'] = nrm(ks[1], (DEC_BATCH, DEC_SEQ, D_MODEL), f32)
    d['state_mlstm_C'] = 0.5 * nrm(ks[2], (DEPTH, DEC_BATCH, MLSTM_HEADS, HEAD_DIM, HEAD_DIM), f32)
    d['state_mlstm_n'] = 0.5 * nrm(ks[3], (DEPTH, DEC_BATCH, MLSTM_HEADS, HEAD_DIM), f32)
    d['state_mlstm_m'] = jax.random.uniform(ks[4], (DEPTH, DEC_BATCH, MLSTM_HEADS), f32, 0.0, 4.0)
    d['state_conv'] = nrm(ks[5], (DEPTH, DEC_BATCH, CONV_WIDTH - 1, CONV_CH), f32)
    d['p_prompt'] = nrm(ks[6], (DEPTH, BATCH, SEQ, PLE_DIM), f32)
    d['p_sample'] = nrm(ks[7], (DEPTH, DEC_BATCH, DEC_SEQ, PLE_DIM), f32)
    d['norm_mix'] = 1.0 + 0.02 * nrm(ks[8], (DEPTH, D_MODEL), f32)
    d['w_in'] = nrm(ks[9], (DEPTH, D_MODEL, N_IN), f32) * D_MODEL ** -0.5
    d['b_gate_i'] = 0.1 * nrm(ks[10], (DEPTH, MLSTM_HEADS), f32)
    d['b_gate_f'] = jnp.linspace(3.0, 6.0, MLSTM_HEADS, dtype=f32)[None, :] + 0.01 * nrm(ks[11], (DEPTH, MLSTM_HEADS), f32)
    d['mh_norm'] = 1.0 + 0.02 * nrm(ks[12], (DEPTH, MLSTM_W), f32)
    d['conv_w'] = nrm(ks[13], (DEPTH, CONV_WIDTH, CONV_CH), f32) * CONV_WIDTH ** -0.5
    d['w_out'] = nrm(ks[14], (DEPTH, MLSTM_W + CONV_CH, D_MODEL), f32) * (MLSTM_W + CONV_CH) ** -0.5
    d['norm_mlp'] = 1.0 + 0.02 * nrm(ks[15], (DEPTH, D_MODEL), f32)
    d['w_up'] = nrm(ks[16], (DEPTH, D_MODEL, D_FF), f32) * D_MODEL ** -0.5
    d['w_down'] = nrm(ks[17], (DEPTH, D_FF, D_MODEL), f32) * D_FF ** -0.5
    d['norm_ple'] = 1.0 + 0.02 * nrm(ks[18], (DEPTH, D_MODEL), f32)
    d['w_ple_gate'] = nrm(ks[19], (DEPTH, D_MODEL, D_MODEL), f32) * D_MODEL ** -0.5
    d['w_ple_proj'] = nrm(ks[20], (DEPTH, PLE_DIM, D_MODEL), f32) * PLE_DIM ** -0.5
    d['norm_final'] = 1.0 + 0.02 * nrm(ks[21], (D_MODEL,), f32)
    return d


def reference(x_prompt, x_sample, state_mlstm_C, state_mlstm_n, state_mlstm_m, state_conv,
              p_prompt, p_sample, norm_mix, w_in, b_gate_i, b_gate_f, mh_norm, conv_w, w_out,
              norm_mlp, w_up, w_down, norm_ple, w_ple_gate, w_ple_proj, norm_final):
    f32 = jnp.float32
    Bp = x_prompt.shape[0]
    xp = x_prompt
    xs = x_sample
    pC, pn, pm, pconv = [], [], [], []
    sC, sn, sm, sconv = [], [], [], []
    for i in range(DEPTH):
        params = (norm_mix[i], w_in[i], b_gate_i[i], b_gate_f[i], mh_norm[i], conv_w[i], w_out[i],
                  norm_mlp[i], w_up[i], w_down[i], norm_ple[i], w_ple_gate[i], w_ple_proj[i])
        conv0 = jnp.zeros((Bp, CONV_WIDTH - 1, CONV_CH), xp.dtype)
        C0 = jnp.zeros((Bp, MLSTM_HEADS, HEAD_DIM, HEAD_DIM), f32)
        n0 = jnp.zeros((Bp, MLSTM_HEADS, HEAD_DIM), f32)
        m0 = jnp.full((Bp, MLSTM_HEADS), M_INIT, f32)
        xp, b1, c1, n1, m1 = layer(xp, p_prompt[i], conv0, C0, n0, m0, *params)
        pC.append(c1); pn.append(n1); pm.append(m1); pconv.append(b1)
        xs, b2, c2, n2, m2 = layer(xs, p_sample[i], state_conv[i], state_mlstm_C[i],
                                   state_mlstm_n[i], state_mlstm_m[i], *params)
        sC.append(c2); sn.append(n2); sm.append(m2); sconv.append(b2)
    y_prompt = rmsnorm(xp, norm_final)
    y_sample = rmsnorm(xs, norm_final)
    return (y_prompt, y_sample,
            jnp.stack(pC), jnp.stack(pn), jnp.stack(pm), jnp.stack(pconv),
            jnp.stack(sC), jnp.stack(sn), jnp.stack(sm), jnp.stack(sconv))
```

```cpp
#include <hip/hip_runtime.h>
#include <hip/hip_cooperative_groups.h>
#include <cstdio>
#include <cstdint>
namespace cg = cooperative_groups;
namespace pg8 {
#define PG8_LAS __attribute__((address_space(3)))
typedef unsigned short bf16_t;
typedef short bf16x8 __attribute__((ext_vector_type(8)));
typedef float f32x4 __attribute__((ext_vector_type(4)));
typedef unsigned u32x4 __attribute__((ext_vector_type(4)));
constexpr int BM = 256, BK = 64, HALF = 128, HTB = HALF * BK * 2  , STAGE_BYTES = 8 * HTB, NXCD = 8, WGM = 8;

__host__ __device__ __forceinline__ int lds_byte(int r, int c) { const int st = (r >> 4) * 2 + (c >> 5), rr = r & 15, cc = c & 31, ob = rr * 64 + cc * 2; return st * 1024 + (ob ^ (((ob >> 9) & 1) << 5)); }
__host__ __device__ __forceinline__ void stage_rc(int b, int& R, int& C) { const int st = b / 1024, sb = b % 1024, swz = sb ^ (((sb >> 9) & 1) << 5); R = (st >> 1) * 16 + swz / 64; C = (st & 1) * 32 + (swz % 64) / 2; }
__host__ __device__ __forceinline__ int perm32(int rho) { const int n = rho >> 4, i = rho & 15; return 8 * (i >> 2) + 4 * n + (i & 3); }

struct Unit { int pm, pn; };
struct Gemm { const bf16_t* A; const bf16_t* Bt; int M, N, K; };

struct StaticOrder {
    int nM, nN, nwg, G, c;
    __host__ __device__ void init(int M, int N, int G_, int c_) { nM = M / BM; nN = N / BM; nwg = nM * nN; G = G_; c = c_; }
    __host__ __device__ bool next(int i, Unit& u) const {
        const long L = (long)i * G + c; if (L >= nwg) return false;
        int wgid = (int)L; { const int q = nwg / NXCD, r = nwg % NXCD, xcd = wgid % NXCD, off = wgid / NXCD; wgid = (xcd < r ? xcd * (q + 1) : r * (q + 1) + (xcd - r) * q) + off; }
        const int nig = WGM * nN, gid = wgid / nig, fm = gid * WGM, gsz = (nM - fm) < WGM ? (nM - fm) : WGM;
        u.pm = fm + ((wgid % nig) % gsz); u.pn = (wgid % nig) / gsz; return true;
    }
    __device__ __forceinline__ void a_ready(const Unit&) const {}
    __device__ __forceinline__ void done(const Unit&) const {}
};

__device__ __forceinline__ unsigned cvt_pk_bf16(float lo, float hi) { unsigned r; asm volatile("v_cvt_pk_bf16_f32 %0, %1, %2" : "=v"(r) : "v"(lo), "v"(hi)); return r; }
template <class Epi, class Sched, bool ALIGN_EPI = false, bool SP2 = false>
__device__ __forceinline__ void gemm_phase(PG8_LAS unsigned char* lds, const Gemm g, const Sched& S, const Epi& E) {
    const int tid = threadIdx.x, wid = __builtin_amdgcn_readfirstlane(tid >> 6), lane = tid & 63, wr = wid >> 2, wc = wid & 3, fr = lane & 15, fq = lane >> 4;
    const int K = g.K, nt = K / BK;
    unsigned voffA[2], voffB[2];
#pragma unroll
    for (int i = 0; i < 2; ++i) { int R, C; stage_rc(tid * 16 + i * 8192, R, C); const int Rb = Epi::PERM ? ((R & ~31) + perm32(R & 31)) : R;
        voffA[i] = (unsigned)(R * K + C) * 2u; voffB[i] = (unsigned)(Rb * K + C) * 2u; }
    const size_t kstep = (size_t)(BK * 2);
    const size_t hstep = (size_t)HALF * K * 2;
    const size_t tstep = 2 * hstep;
    const unsigned ldsw = (unsigned)wid * 1024u;
    const int aoff = lds_byte(wr * 64 + fr, fq * 8), boff = lds_byte(wc * 32 + fr, fq * 8);
#define PG8_SA(b, h) (((b) * 2 + (h)) * HTB)
#define PG8_SB(b, h) ((4 + (b) * 2 + (h)) * HTB)
#define PG8_STAGE(bufoff, gbase, voff) do { _Pragma("unroll") for (int _i = 0; _i < 2; ++_i) \
        __builtin_amdgcn_global_load_lds((const unsigned*)((const char*)(gbase) + (voff)[_i]), (PG8_LAS unsigned*)(lds + (bufoff) + ldsw + _i * 8192), 16, 0, 0); } while (0)
#define PG8_LDA(dst, b, h) do { _Pragma("unroll") for (int m = 0; m < 4; ++m) _Pragma("unroll") for (int k = 0; k < 2; ++k) dst[m][k] = *(const PG8_LAS bf16x8*)(lds + PG8_SA(b, h) + aoff + m * 2048 + k * 1024); } while (0)
#define PG8_LDB(dst, b, h) do { _Pragma("unroll") for (int n = 0; n < 2; ++n) _Pragma("unroll") for (int k = 0; k < 2; ++k) dst[n][k] = *(const PG8_LAS bf16x8*)(lds + PG8_SB(b, h) + boff + n * 2048 + k * 1024); } while (0)
#define PG8_MMA(ai, bj, At, Bt) do { __builtin_amdgcn_s_setprio(1); _Pragma("unroll") for (int m = 0; m < 4; ++m) _Pragma("unroll") for (int n = 0; n < 2; ++n) _Pragma("unroll") for (int k = 0; k < 2; ++k) \
        acc[ai][bj][m][n] = __builtin_amdgcn_mfma_f32_16x16x32_bf16(Bt[n][k], At[m][k], acc[ai][bj][m][n], 0, 0, 0); __builtin_amdgcn_s_setprio(0); } while (0)
#define PG8_WAIT_V(n) asm volatile("s_waitcnt vmcnt(" #n ")" ::: "memory")
#define PG8_WAIT_L(n) asm volatile("s_waitcnt lgkmcnt(" #n ")" ::: "memory")
#define PG8_BAR __builtin_amdgcn_s_barrier()
#define PG8_SCHED __builtin_amdgcn_sched_barrier(0)
    Unit cur, nxt; int ui = 0;
    if (!S.next(0, cur)) return;
    f32x4 acc[2][2][4][2];
#pragma unroll
    for (int a = 0; a < 2; ++a)
#pragma unroll
        for (int b = 0; b < 2; ++b)
#pragma unroll
            for (int m = 0; m < 4; ++m)
#pragma unroll
                for (int n = 0; n < 2; ++n) acc[a][b][m][n] = (f32x4){0.f, 0.f, 0.f, 0.f};
    bf16x8 At[4][2], B0[2][2], B1[2][2];
    const char* cA = (const char*)g.A + (size_t)cur.pm * tstep; const char* cB = (const char*)g.Bt + (size_t)cur.pn * tstep;
    S.a_ready(cur);
    if constexpr (SP2) {
        PG8_STAGE(PG8_SB(0, 0), cB, voffB); PG8_STAGE(PG8_SB(0, 1), cB + hstep, voffB); PG8_STAGE(PG8_SA(0, 0), cA, voffA); PG8_STAGE(PG8_SA(0, 1), cA + hstep, voffA);
        if (wr == 1) PG8_BAR;
        PG8_WAIT_V(2); PG8_BAR;
        PG8_STAGE(PG8_SB(1, 0), cB + kstep, voffB); PG8_STAGE(PG8_SA(1, 0), cA + kstep, voffA); PG8_STAGE(PG8_SB(1, 1), cB + hstep + kstep, voffB);
        PG8_WAIT_V(6); PG8_BAR;
    } else {
        PG8_STAGE(PG8_SB(0, 0), cB, voffB); PG8_STAGE(PG8_SA(0, 0), cA, voffA); PG8_STAGE(PG8_SB(0, 1), cB + hstep, voffB); PG8_STAGE(PG8_SA(0, 1), cA + hstep, voffA);
        if (wr == 1) PG8_BAR;
        PG8_WAIT_V(4); PG8_BAR;
        PG8_STAGE(PG8_SB(1, 0), cB + kstep, voffB); PG8_STAGE(PG8_SA(1, 0), cA + kstep, voffA); PG8_STAGE(PG8_SB(1, 1), cB + hstep + kstep, voffB);
        PG8_WAIT_V(6); PG8_BAR;
    }
    for (;;) {
        const bool has_next = S.next(ui + 1, nxt);
        const char* nA = has_next ? (const char*)g.A + (size_t)nxt.pm * tstep : cA; const char* nB = has_next ? (const char*)g.Bt + (size_t)nxt.pn * tstep : cB;
        for (int t = 0; t < nt; t += 2) {
            const bool last = (t == nt - 2);
            const char* a1 = cA + (size_t)(t + 1) * kstep;
            const char* a2 = last ? nA : cA + (size_t)(t + 2) * kstep; const char* b2 = last ? nB : cB + (size_t)(t + 2) * kstep;
            const char* a3 = a2 + kstep; const char* b3 = b2 + kstep;
            if (last && has_next) S.a_ready(nxt);
            if constexpr (SP2) {
            PG8_LDB(B0, 0, 0); PG8_LDB(B1, 0, 1); PG8_SCHED; PG8_LDA(At, 0, 0); PG8_STAGE(PG8_SA(1, 1), a1 + hstep, voffA);
            PG8_WAIT_V(8); PG8_WAIT_L(0); PG8_BAR; PG8_MMA(0, 0, At, B0); PG8_MMA(0, 1, At, B1); PG8_BAR; PG8_SCHED;
            PG8_LDA(At, 0, 1); PG8_STAGE(PG8_SB(0, 0), b2, voffB); PG8_STAGE(PG8_SB(0, 1), b2 + hstep, voffB); PG8_STAGE(PG8_SA(0, 0), a2, voffA);
            PG8_WAIT_V(8); PG8_WAIT_L(0); PG8_BAR; PG8_MMA(1, 0, At, B0); PG8_MMA(1, 1, At, B1); PG8_BAR; PG8_SCHED;
            PG8_LDB(B0, 1, 0); PG8_LDB(B1, 1, 1); PG8_SCHED; PG8_LDA(At, 1, 0); PG8_STAGE(PG8_SA(0, 1), a2 + hstep, voffA);
            PG8_WAIT_V(8); PG8_WAIT_L(0); PG8_BAR; PG8_MMA(0, 0, At, B0); PG8_MMA(0, 1, At, B1); PG8_BAR; PG8_SCHED;
            PG8_LDA(At, 1, 1); PG8_STAGE(PG8_SB(1, 0), b3, voffB); PG8_STAGE(PG8_SB(1, 1), b3 + hstep, voffB); PG8_STAGE(PG8_SA(1, 0), a3, voffA);
            PG8_WAIT_V(8); PG8_WAIT_L(0); PG8_BAR; PG8_MMA(1, 0, At, B0); PG8_MMA(1, 1, At, B1); PG8_BAR; PG8_SCHED;
            } else {
            PG8_LDB(B0, 0, 0); PG8_SCHED; PG8_LDA(At, 0, 0); PG8_STAGE(PG8_SA(1, 1), a1 + hstep, voffA);
            PG8_WAIT_L(8); PG8_BAR; PG8_WAIT_L(0); PG8_MMA(0, 0, At, B0); PG8_BAR; PG8_SCHED;
            PG8_LDB(B1, 0, 1); PG8_STAGE(PG8_SB(0, 0), b2, voffB);
            PG8_BAR; PG8_WAIT_L(0); PG8_MMA(0, 1, At, B1); PG8_BAR;
            PG8_LDA(At, 0, 1); PG8_STAGE(PG8_SA(0, 0), a2, voffA);
            PG8_BAR; PG8_WAIT_L(0); PG8_MMA(1, 0, At, B0); PG8_BAR; PG8_SCHED;
            PG8_STAGE(PG8_SB(0, 1), b2 + hstep, voffB);
            PG8_WAIT_V(6); PG8_BAR; PG8_MMA(1, 1, At, B1); PG8_BAR;
            PG8_LDB(B0, 1, 0); PG8_SCHED; PG8_LDA(At, 1, 0); PG8_STAGE(PG8_SA(0, 1), a2 + hstep, voffA);
            PG8_WAIT_L(8); PG8_BAR; PG8_WAIT_L(0); PG8_MMA(0, 0, At, B0); PG8_BAR; PG8_SCHED;
            PG8_LDB(B1, 1, 1); PG8_STAGE(PG8_SB(1, 0), b3, voffB);
            PG8_BAR; PG8_WAIT_L(0); PG8_MMA(0, 1, At, B1); PG8_BAR;
            PG8_LDA(At, 1, 1); PG8_STAGE(PG8_SA(1, 0), a3, voffA);
            PG8_BAR; PG8_WAIT_L(0); PG8_MMA(1, 0, At, B0); PG8_BAR; PG8_SCHED;
            PG8_STAGE(PG8_SB(1, 1), b3 + hstep, voffB);
            PG8_WAIT_V(6); PG8_BAR; PG8_MMA(1, 1, At, B1); PG8_BAR;
            }
        }
        if constexpr (ALIGN_EPI) { if (wr == 0) PG8_BAR; }
        if constexpr (!Epi::AFTER_DRAIN) { E(acc, cur, wr, wc, fr, fq); S.done(cur); }
        if (!has_next) break;
#pragma unroll
        for (int a = 0; a < 2; ++a)
#pragma unroll
            for (int b = 0; b < 2; ++b)
#pragma unroll
                for (int m = 0; m < 4; ++m)
#pragma unroll
                    for (int n = 0; n < 2; ++n) acc[a][b][m][n] = (f32x4){0.f, 0.f, 0.f, 0.f};
        cur = nxt; cA = nA; cB = nB; ++ui;
        if constexpr (ALIGN_EPI) { if (wr == 1) PG8_BAR; }
    }
    PG8_WAIT_V(0);
    if constexpr (!ALIGN_EPI) { if (wr == 0) PG8_BAR; }
    PG8_BAR;
    if constexpr (Epi::AFTER_DRAIN) { E.fused(acc, cur, wr, wc, fr, fq, lds, wid, lane); S.done(cur); }
#undef PG8_SA
#undef PG8_SB
#undef PG8_STAGE
#undef PG8_LDA
#undef PG8_LDB
#undef PG8_MMA
#undef PG8_WAIT_V
#undef PG8_WAIT_L
#undef PG8_BAR
#undef PG8_SCHED
}
}

#ifndef MK_PER_PHASE
#define MK_PER_PHASE 0
#endif

constexpr int D = 1024, SEQ = 2048, NB = 8, MP = NB * SEQ, MS = 128, MT = MP + MS;
constexpr int NIN = 3592, NZ = 3584, FF = 4096, PLE = 256, NH = 4, HD = 128, CH = 64, NCH = SEQ / CH, NITEM = NB * NH * NCH;
constexpr float EPS = 1e-6f, M_INIT = -1e30f;
constexpr size_t OUT_Y = 0, OUT_PC = (size_t)MT * D, OUT_PN = OUT_PC + 524288, OUT_PM = OUT_PN + 4096, OUT_PCONV = OUT_PM + 32,
                 OUT_SC = OUT_PCONV + 8192, OUT_SN = OUT_SC + 8388608, OUT_SM = OUT_SN + 65536, OUT_SCONV = OUT_SM + 512, OUT_END = OUT_SCONV + 131072;
constexpr size_t MiB = 1u << 20;
constexpr size_t WS_SMALL = 0;
constexpr size_t WS_SSP1 = 1 * MiB, WS_SSP2 = 2 * MiB;
constexpr size_t WS_GATES = 4 * MiB;
constexpr size_t WS_UN = 5 * MiB, WS_NPREV = 5 * MiB + 512 * 1024;
constexpr size_t WS_W1T = 6 * MiB, WS_WOT = 13 * MiB, WS_WUPT = 15 * MiB, WS_WDNT = 23 * MiB, WS_WGT = 31 * MiB, WS_WPT = 33 * MiB;
constexpr size_t WS_PB = 34 * MiB;
constexpr size_t WS_H1 = 43 * MiB;
constexpr size_t WS_PP = 76 * MiB;
constexpr size_t WS_MIX = 109 * MiB;
constexpr size_t WS_Z = 142 * MiB;
constexpr size_t WS_HF = 109 * MiB;
constexpr size_t WS_END = 255 * MiB;
static_assert(WS_Z + (size_t)MT * NZ * 2 <= WS_END && WS_HF + (size_t)MT * FF * 2 <= WS_END, "ws map");

constexpr int LDS_BYTES = 147456, LDS_RED = 131072;

#define GAS __attribute__((address_space(1)))
#define LAS __attribute__((address_space(3)))
typedef unsigned short bf16;
typedef float f32x4 __attribute__((ext_vector_type(4)));
typedef float f32x2 __attribute__((ext_vector_type(2)));
typedef short bf16x8 __attribute__((ext_vector_type(8)));
typedef unsigned u32x4 __attribute__((ext_vector_type(4)));
typedef unsigned u32x2 __attribute__((ext_vector_type(2)));
typedef __bf16 bf16x2_t __attribute__((ext_vector_type(2)));
__device__ __forceinline__ unsigned cvt_pk_bf16(float lo, float hi) { f32x2 v = {lo, hi}; bf16x2_t r = __builtin_convertvector(v, bf16x2_t); return __builtin_bit_cast(unsigned, r); }

__device__ __forceinline__ float bf2f(unsigned b) { return __uint_as_float(b << 16); }
__device__ __forceinline__ float bflo(unsigned w) { return __uint_as_float(w << 16); }
__device__ __forceinline__ float bfhi(unsigned w) { return __uint_as_float(w & 0xffff0000u); }
__device__ __forceinline__ unsigned f2bf(float f) { unsigned u = __float_as_uint(f); return (u + 0x7fffu + ((u >> 16) & 1u)) >> 16; }
__device__ __forceinline__ float wave_sum(float v) {
#pragma unroll
    for (int o = 1; o < 64; o <<= 1) v += __shfl_xor(v, o);
    return v;
}
__device__ __forceinline__ float wave_max(float v) {
#pragma unroll
    for (int o = 1; o < 64; o <<= 1) v = fmaxf(v, __shfl_xor(v, o));
    return v;
}
__device__ __forceinline__ float sigmoidf_(float x) { return 1.0f / (1.0f + __expf(-x)); }
__device__ __forceinline__ float logsigmoid_(float x) { return fminf(x, 0.f) - log1pf(expf(-fabsf(x))); }

struct Params { const float* in[22]; float* out; unsigned char* ws; int ph_lo, ph_hi; };

__device__ __forceinline__ void p0_transpose_item(const float* W, int K, int ldw, int c0, int ncols, bf16* WT, int row_off, const float* g, float sc_first512, LAS float* scr, int item, int lane) {
    const int nblk = ncols / 32, kb = item / nblk, nb = item % nblk, k0 = 64 * kb, n0 = 32 * nb;
    const float sc = (n0 < 512) ? sc_first512 : 1.0f;
#pragma unroll 8
    for (int i = 0; i < 32; ++i) { const int kk = 2 * i + (lane >> 5); float v = W[(size_t)(k0 + kk) * ldw + c0 + n0 + (lane & 31)]; if (g) v *= g[k0 + kk]; scr[kk * 33 + (lane & 31)] = v * sc; }
    asm volatile("s_waitcnt lgkmcnt(0)" ::: "memory");
    const int c = lane & 7;
#pragma unroll
    for (int j = 0; j < 4; ++j) { const int n = (lane >> 3) + 8 * j; const LAS float* s = scr + (8 * c) * 33 + n;
        u32x4 o; o.x = cvt_pk_bf16(s[0 * 33], s[1 * 33]); o.y = cvt_pk_bf16(s[2 * 33], s[3 * 33]); o.z = cvt_pk_bf16(s[4 * 33], s[5 * 33]); o.w = cvt_pk_bf16(s[6 * 33], s[7 * 33]);
        *(u32x4*)(WT + (size_t)(row_off + n0 + n) * K + k0 + 8 * c) = o; }
    asm volatile("s_waitcnt lgkmcnt(0)" ::: "memory");
}

__device__ __forceinline__ void phase0(const Params& P, LAS unsigned char* lds, int wg, int nwg) {
    const int tid = threadIdx.x, lane = tid & 63, wave = tid >> 6;
    unsigned char* ws = P.ws;
    LAS float* scr = (LAS float*)(lds + wave * 8704);
    LAS float* wgt = (LAS float*)(lds + 73728);
    const float* w_in = P.in[9];
    for (int i = tid; i < 1024 * 8; i += 512) wgt[i] = w_in[(size_t)(i >> 3) * NIN + 2048 + (i & 7)];
    __syncthreads();
    const int gw = wg * 8 + wave, NGW = nwg * 8;
    {
        const float* g = P.in[8];
        f32x4 gv[4];
#pragma unroll
        for (int j = 0; j < 4; ++j) gv[j] = *(const f32x4*)(g + 4 * lane + 256 * j);
        bf16* H1 = (bf16*)(ws + WS_H1); float* GATES = (float*)(ws + WS_GATES);
        const float* bgi = P.in[10]; const float* bgf = P.in[11];
        for (int m = gw; m < MT; m += NGW) {
            const float* xrow = (m < MP) ? P.in[0] + (size_t)m * D : P.in[1] + (size_t)(m - MP) * D;
            f32x4 v[4]; float s = 0.f;
#pragma unroll
            for (int j = 0; j < 4; ++j) { v[j] = *(const f32x4*)(xrow + 4 * lane + 256 * j); s += (v[j].x * v[j].x + v[j].y * v[j].y) + (v[j].z * v[j].z + v[j].w * v[j].w); }
            const float r = rsqrtf(wave_sum(s) * (1.f / D) + EPS);
            float d0 = 0, d1 = 0, d2 = 0, d3 = 0, d4 = 0, d5 = 0, d6 = 0, d7 = 0;
#pragma unroll
            for (int j = 0; j < 4; ++j) {
                v[j] = v[j] * r * gv[j];
                u32x2 o; o.x = cvt_pk_bf16(v[j].x, v[j].y); o.y = cvt_pk_bf16(v[j].z, v[j].w);
                *(u32x2*)(H1 + (size_t)m * D + 4 * lane + 256 * j) = o;
#pragma unroll
                for (int e = 0; e < 4; ++e) { const int k = 4 * lane + 256 * j + e; const f32x4 wa = *(const LAS f32x4*)(wgt + k * 8), wb = *(const LAS f32x4*)(wgt + k * 8 + 4); const float hv = v[j][e];
                    d0 += hv * wa.x; d1 += hv * wa.y; d2 += hv * wa.z; d3 += hv * wa.w; d4 += hv * wb.x; d5 += hv * wb.y; d6 += hv * wb.z; d7 += hv * wb.w; }
            }
            d0 = wave_sum(d0); d1 = wave_sum(d1); d2 = wave_sum(d2); d3 = wave_sum(d3); d4 = wave_sum(d4); d5 = wave_sum(d5); d6 = wave_sum(d6); d7 = wave_sum(d7);
            if (lane < 8) {
                float dv = lane == 0 ? d0 : lane == 1 ? d1 : lane == 2 ? d2 : lane == 3 ? d3 : lane == 4 ? d4 : lane == 5 ? d5 : lane == 6 ? d6 : d7;
                float o;
                if (lane < 4) o = dv + bgi[lane]; else o = logsigmoid_(dv + bgf[lane - 4]);
                GATES[(size_t)m * 8 + lane] = o;
            }
        }
    }
    {
        bf16* PB = (bf16*)(ws + WS_PB);
        const int total = MT * PLE / 8;
        for (int i = wg * 512 + tid; i < total; i += nwg * 512) {
            const size_t e = (size_t)i * 8;
            const float* src = (e < (size_t)MP * PLE) ? P.in[6] + e : P.in[7] + (e - (size_t)MP * PLE);
            const f32x4 a = *(const f32x4*)src, b = *(const f32x4*)(src + 4);
            u32x4 o; o.x = cvt_pk_bf16(a.x, a.y); o.y = cvt_pk_bf16(a.z, a.w); o.z = cvt_pk_bf16(b.x, b.y); o.w = cvt_pk_bf16(b.z, b.w);
            *(u32x4*)(PB + e) = o;
        }
    }
    {
        constexpr int I1 = 16 * 64, I2 = 16 * 48, I3 = 16 * 32, I4 = 16 * 128, I5 = 64 * 32, I6 = 16 * 32, I7 = 4 * 32;
        constexpr int NIT = I1 + I2 + I3 + I4 + I5 + I6 + I7;
        for (int it = gw; it < NIT; it += NGW) {
            int r = it;
            if (r < I1) { p0_transpose_item(P.in[9], 1024, NIN, 0, 2048, (bf16*)(ws + WS_W1T), 0, nullptr, 0.08838834764831845f, scr, r, lane); continue; } r -= I1;
            if (r < I2) { p0_transpose_item(P.in[9], 1024, NIN, 2056, 1536, (bf16*)(ws + WS_W1T), 2048, nullptr, 1.0f, scr, r, lane); continue; } r -= I2;
            if (r < I3) { p0_transpose_item(P.in[14], 1024, 1024, 0, 1024, (bf16*)(ws + WS_WOT), 0, nullptr, 1.0f, scr, r, lane); continue; } r -= I3;
            if (r < I4) { p0_transpose_item(P.in[16], 1024, 4096, 0, 4096, (bf16*)(ws + WS_WUPT), 0, P.in[15], 1.0f, scr, r, lane); continue; } r -= I4;
            if (r < I5) { p0_transpose_item(P.in[17], 4096, 1024, 0, 1024, (bf16*)(ws + WS_WDNT), 0, nullptr, 1.0f, scr, r, lane); continue; } r -= I5;
            if (r < I6) { p0_transpose_item(P.in[19], 1024, 1024, 0, 1024, (bf16*)(ws + WS_WGT), 0, P.in[18], 1.0f, scr, r, lane); continue; } r -= I6;
            p0_transpose_item(P.in[20], 256, 1024, 0, 1024, (bf16*)(ws + WS_WPT), 0, nullptr, 1.0f, scr, r, lane);
        }
    }
}

template <int KS, class F>
__device__ __forceinline__ void small_gemm(const bf16* A, const bf16* Bt, int N, int K, LAS float* red, int wg, int nwg, const F& epi) {
    const int tid = threadIdx.x, lane = tid & 63, wave = tid >> 6, fr = lane & 15, fq = lane >> 4;
    constexpr int TPW = 8 / KS;
    const int sub = wave / KS, kp = wave % KS;
    const int ntiles = 8 * (N / 16), nit = (ntiles + nwg * TPW - 1) / (nwg * TPW);
    const int klen = K / KS, steps = klen / 32;
    for (int it = 0; it < nit; ++it) {
        const int T = (it * nwg + wg) * TPW + sub; const bool valid = T < ntiles;
        const int ct = T >> 3, rt = T & 7;
        f32x4 acc = {0.f, 0.f, 0.f, 0.f};
        if (valid) {
            const bf16* ap = A + (size_t)(rt * 16 + fr) * K + kp * klen + fq * 8;
            const bf16* bp = Bt + (size_t)(ct * 16 + fr) * K + kp * klen + fq * 8;
#pragma unroll 8
            for (int s = 0; s < steps; ++s) { const bf16x8 a = *(const bf16x8*)(ap + s * 32), b = *(const bf16x8*)(bp + s * 32); acc = __builtin_amdgcn_mfma_f32_16x16x32_bf16(b, a, acc, 0, 0, 0); }
        }
        if (KS > 1) {
            *(LAS f32x4*)(red + wave * 256 + lane * 4) = acc;
            __syncthreads();
            if (kp == 0) {
#pragma unroll
                for (int j = 1; j < KS; ++j) acc += *(const LAS f32x4*)(red + (wave + j) * 256 + lane * 4);
            }
        }
        if (valid && kp == 0) epi(rt * 16 + fr, ct * 16 + fq * 4, acc);
        if (KS > 1) __syncthreads();
    }
}

struct EpiStoreBf16 {
    static constexpr bool PERM = true, AFTER_DRAIN = false;
    bf16* O; int ldc;
    __device__ __forceinline__ void operator()(const f32x4 (&acc)[2][2][4][2], const pg8::Unit& u, int wr, int wc, int fr, int fq) const {
        const int row0 = u.pm * 256 + wr * 64 + fr, col0 = u.pn * 256 + wc * 32 + 8 * fq;
#pragma unroll
        for (int ai = 0; ai < 2; ++ai)
#pragma unroll
            for (int m = 0; m < 4; ++m) { bf16* rowp = O + (size_t)(row0 + ai * 128 + m * 16) * ldc + col0;
#pragma unroll
                for (int bj = 0; bj < 2; ++bj) { const f32x4 v0 = acc[ai][bj][m][0], v1 = acc[ai][bj][m][1];
                    u32x4 w; w.x = cvt_pk_bf16(v0[0], v0[1]); w.y = cvt_pk_bf16(v0[2], v0[3]); w.z = cvt_pk_bf16(v1[0], v1[1]); w.w = cvt_pk_bf16(v1[2], v1[3]);
                    *(u32x4*)(rowp + bj * 128) = w; }
                asm volatile("" ::: "memory"); }
    }
};
struct EpiRes {
    static constexpr bool PERM = true, AFTER_DRAIN = false;
    const float* base; float* XO; bf16* XB; float* SSP;
    __device__ __forceinline__ void operator()(const f32x4 (&acc)[2][2][4][2], const pg8::Unit& u, int wr, int wc, int fr, int fq) const {
        const int row0 = u.pm * 256 + wr * 64 + fr, col0 = u.pn * 256 + wc * 32 + 8 * fq;
#pragma unroll
        for (int ai = 0; ai < 2; ++ai)
#pragma unroll
            for (int m = 0; m < 4; ++m) { const int row = row0 + ai * 128 + m * 16; const size_t off = (size_t)row * D + col0; float ss = 0.f;
#pragma unroll
                for (int bj = 0; bj < 2; ++bj) {
                    const f32x4 b0 = *(const f32x4*)(base + off + bj * 128), b1 = *(const f32x4*)(base + off + bj * 128 + 4);
                    const f32x4 v0 = acc[ai][bj][m][0] + b0, v1 = acc[ai][bj][m][1] + b1;
                    *(f32x4*)(XO + off + bj * 128) = v0; *(f32x4*)(XO + off + bj * 128 + 4) = v1;
                    u32x4 w; w.x = cvt_pk_bf16(v0[0], v0[1]); w.y = cvt_pk_bf16(v0[2], v0[3]); w.z = cvt_pk_bf16(v1[0], v1[1]); w.w = cvt_pk_bf16(v1[2], v1[3]);
                    *(u32x4*)(XB + off + bj * 128) = w;
                    ss += (v0[0] * v0[0] + v0[1] * v0[1]) + (v0[2] * v0[2] + v0[3] * v0[3]) + (v1[0] * v1[0] + v1[1] * v1[1]) + (v1[2] * v1[2] + v1[3] * v1[3]); }
                ss += __shfl_xor(ss, 16); ss += __shfl_xor(ss, 32);
                if (fq == 0) SSP[(size_t)row * 16 + u.pn * 4 + wc] = ss;
                asm volatile("" ::: "memory"); }
    }
};
__device__ __forceinline__ float row_rs16(const float* SSP, int row) {
    const f32x4 a = *(const f32x4*)(SSP + (size_t)row * 16), b = *(const f32x4*)(SSP + (size_t)row * 16 + 4), c = *(const f32x4*)(SSP + (size_t)row * 16 + 8), d = *(const f32x4*)(SSP + (size_t)row * 16 + 12);
    const float s = ((a.x + a.y) + (a.z + a.w)) + ((b.x + b.y) + (b.z + b.w)) + ((c.x + c.y) + (c.z + c.w)) + ((d.x + d.y) + (d.z + d.w));
    return rsqrtf(s * (1.f / D) + EPS);
}
__device__ __forceinline__ float row_rs64(const float* SSS, int row) {
    float s = 0.f;
#pragma unroll
    for (int j = 0; j < 16; ++j) { const f32x4 a = *(const f32x4*)(SSS + (size_t)row * 64 + 4 * j); s += (a.x + a.y) + (a.z + a.w); }
    return rsqrtf(s * (1.f / D) + EPS);
}
struct EpiUp {
    static constexpr bool PERM = true, AFTER_DRAIN = false;
    bf16* O; const float* SSP;
    __device__ __forceinline__ void operator()(const f32x4 (&acc)[2][2][4][2], const pg8::Unit& u, int wr, int wc, int fr, int fq) const {
        const int row0 = u.pm * 256 + wr * 64 + fr, col0 = u.pn * 256 + wc * 32 + 8 * fq;
#pragma unroll
        for (int ai = 0; ai < 2; ++ai)
#pragma unroll
            for (int m = 0; m < 4; ++m) { const int row = row0 + ai * 128 + m * 16; const float r = row_rs16(SSP, row); bf16* rowp = O + (size_t)row * FF + col0;
#pragma unroll
                for (int bj = 0; bj < 2; ++bj) { f32x4 v0 = acc[ai][bj][m][0] * r, v1 = acc[ai][bj][m][1] * r;
#pragma unroll
                    for (int e = 0; e < 4; ++e) { const float a = fmaxf(v0[e], 0.f), b = fmaxf(v1[e], 0.f); v0[e] = a * a; v1[e] = b * b; }
                    u32x4 w; w.x = cvt_pk_bf16(v0[0], v0[1]); w.y = cvt_pk_bf16(v0[2], v0[3]); w.z = cvt_pk_bf16(v1[0], v1[1]); w.w = cvt_pk_bf16(v1[2], v1[3]);
                    *(u32x4*)(rowp + bj * 128) = w; }
                asm volatile("" ::: "memory"); }
    }
};
struct EpiPle {
    static constexpr bool PERM = true, AFTER_DRAIN = false;
    float* X; const bf16* PP; const float* SSP;
    __device__ __forceinline__ void operator()(const f32x4 (&acc)[2][2][4][2], const pg8::Unit& u, int wr, int wc, int fr, int fq) const {
        const int row0 = u.pm * 256 + wr * 64 + fr, col0 = u.pn * 256 + wc * 32 + 8 * fq;
#pragma unroll
        for (int ai = 0; ai < 2; ++ai)
#pragma unroll
            for (int m = 0; m < 4; ++m) { const int row = row0 + ai * 128 + m * 16; const float r = row_rs16(SSP, row); const size_t off = (size_t)row * D + col0;
#pragma unroll
                for (int bj = 0; bj < 2; ++bj) {
                    const f32x4 b0 = *(const f32x4*)(X + off + bj * 128), b1 = *(const f32x4*)(X + off + bj * 128 + 4);
                    const u32x4 pw = *(const u32x4*)(PP + off + bj * 128);
                    const f32x4 a0 = acc[ai][bj][m][0] * r, a1 = acc[ai][bj][m][1] * r;
                    f32x4 v0, v1;
                    v0[0] = b0[0] + sigmoidf_(a0[0]) * bflo(pw.x); v0[1] = b0[1] + sigmoidf_(a0[1]) * bfhi(pw.x); v0[2] = b0[2] + sigmoidf_(a0[2]) * bflo(pw.y); v0[3] = b0[3] + sigmoidf_(a0[3]) * bfhi(pw.y);
                    v1[0] = b1[0] + sigmoidf_(a1[0]) * bflo(pw.z); v1[1] = b1[1] + sigmoidf_(a1[1]) * bfhi(pw.z); v1[2] = b1[2] + sigmoidf_(a1[2]) * bflo(pw.w); v1[3] = b1[3] + sigmoidf_(a1[3]) * bfhi(pw.w);
                    *(f32x4*)(X + off + bj * 128) = v0; *(f32x4*)(X + off + bj * 128 + 4) = v1; }
                asm volatile("" ::: "memory"); }
    }
};
struct UpperHalfOrder {
    int G, c, nM, nN;
    __device__ bool next(int i, pg8::Unit& u) const { const int h = G / 2; if (c < h) return false; const int L = (c - h) + i * (G - h); if (L >= nM * nN) return false; u.pm = L / nN; u.pn = L % nN; return true; }
    __device__ __forceinline__ void a_ready(const pg8::Unit&) const {}
    __device__ __forceinline__ void done(const pg8::Unit&) const {}
};

__device__ __forceinline__ float scan_add(float v, int lane) {
#pragma unroll
    for (int o = 1; o < 64; o <<= 1) { const float t = __shfl_up(v, o); if (lane >= o) v += t; }
    return v;
}
__device__ __forceinline__ float scan_max(float v, int lane) {
#pragma unroll
    for (int o = 1; o < 64; o <<= 1) { const float t = __shfl_up(v, o); if (lane >= o) v = fmaxf(v, t); }
    return v;
}
constexpr int TS = 72;

__device__ __forceinline__ void phase2a(const Params& P, LAS unsigned char* lds, int wg, int nwg) {
    const int tid = threadIdx.x, lane = tid & 63, wave = tid >> 6, fr = lane & 15, fq = lane >> 4;
    unsigned char* ws = P.ws;
    const bf16* Z = (const bf16*)(ws + WS_Z); const float* GATES = (const float*)(ws + WS_GATES);
    bf16* MIX = (bf16*)(ws + WS_MIX);
    float* BL = (float*)(ws + WS_SMALL); float* AMAX = BL + 1024;
    float* U = P.out;
    float* UN = (float*)(ws + WS_UN);
    LAS bf16* Kt = (LAS bf16*)lds; LAS bf16* Vt = Kt + 128 * TS; LAS float* sw = (LAS float*)(lds + 2 * 128 * TS * 2);
    for (int item = wg; item < NITEM; item += nwg) {
        const int b = item >> 7, h = (item >> 5) & 3, c = item & 31, r0 = b * SEQ + c * CH;
        if (wave == 0) {
            const float lf = GATES[(size_t)(r0 + lane) * 8 + 4 + h], ig = GATES[(size_t)(r0 + lane) * 8 + h];
            const float bc = scan_add(lf, lane), a = ig - bc, am = wave_max(a);
            sw[lane] = __expf(a - am);
            if (lane == 63) BL[item] = bc;
            if (lane == 0) AMAX[item] = am;
        }
        __syncthreads();
        {
            const int s = tid >> 3, seg = tid & 7;
            const bf16* zr = Z + (size_t)(r0 + s) * NZ + h * HD + seg * 16;
            const u32x4 k0 = *(const u32x4*)(zr + 512), k1 = *(const u32x4*)(zr + 512 + 8), v0 = *(const u32x4*)(zr + 1024), v1 = *(const u32x4*)(zr + 1024 + 8);
            const float w = sw[s];
            const unsigned kk[8] = {k0.x, k0.y, k0.z, k0.w, k1.x, k1.y, k1.z, k1.w}, vv[8] = {v0.x, v0.y, v0.z, v0.w, v1.x, v1.y, v1.z, v1.w};
#pragma unroll
            for (int e = 0; e < 8; ++e) {
                const int d = seg * 16 + 2 * e;
                Kt[d * TS + s] = (bf16)f2bf(w * bflo(kk[e])); Kt[(d + 1) * TS + s] = (bf16)f2bf(w * bfhi(kk[e]));
                Vt[d * TS + s] = (bf16)(vv[e] & 0xffffu); Vt[(d + 1) * TS + s] = (bf16)(vv[e] >> 16);
            }
        }
        __syncthreads();
        {
            const bf16x8 vf0 = *(const LAS bf16x8*)(Vt + (wave * 16 + fr) * TS + fq * 8), vf1 = *(const LAS bf16x8*)(Vt + (wave * 16 + fr) * TS + 32 + fq * 8);
            float* up = U + (size_t)item * 16384 + (size_t)(wave * 16 + fr) * 128 + fq * 4;
#pragma unroll
            for (int dkt = 0; dkt < 8; ++dkt) {
                const bf16x8 kf0 = *(const LAS bf16x8*)(Kt + (dkt * 16 + fr) * TS + fq * 8), kf1 = *(const LAS bf16x8*)(Kt + (dkt * 16 + fr) * TS + 32 + fq * 8);
                f32x4 acc = {0.f, 0.f, 0.f, 0.f};
                acc = __builtin_amdgcn_mfma_f32_16x16x32_bf16(kf0, vf0, acc, 0, 0, 0);
                acc = __builtin_amdgcn_mfma_f32_16x16x32_bf16(kf1, vf1, acc, 0, 0, 0);
                *(f32x4*)(up + dkt * 16) = acc;
            }
            if (tid < 128) { float s = 0.f;
#pragma unroll 8
                for (int j = 0; j < 64; ++j) s += bf2f(Kt[tid * TS + j]);
                UN[(size_t)item * 128 + tid] = s; }
        }
        __syncthreads();
    }
    {
        const float* cw = P.in[13];
        const int c0 = lane * 8;
        float w0[8], w1[8], w2[8];
#pragma unroll
        for (int e = 0; e < 8; ++e) { w0[e] = cw[c0 + e]; w1[e] = cw[512 + c0 + e]; w2[e] = cw[1024 + c0 + e]; }
        const int gw = wg * 8 + wave, NGW = nwg * 8;
        for (int st = gw; st < MP / 8; st += NGW) {
            const int r0 = st * 8, t0 = r0 & (SEQ - 1);
            float cm2[8], cm1[8];
#pragma unroll
            for (int e = 0; e < 8; ++e) { cm2[e] = 0.f; cm1[e] = 0.f; }
            if (t0 != 0) {
                const u32x4 ga = *(const u32x4*)(Z + (size_t)(r0 - 2) * NZ + 2560 + c0), ua = *(const u32x4*)(Z + (size_t)(r0 - 2) * NZ + 3072 + c0);
                const u32x4 gb2 = *(const u32x4*)(Z + (size_t)(r0 - 1) * NZ + 2560 + c0), ub = *(const u32x4*)(Z + (size_t)(r0 - 1) * NZ + 3072 + c0);
                const unsigned g1[4] = {ga.x, ga.y, ga.z, ga.w}, u1[4] = {ua.x, ua.y, ua.z, ua.w}, g2[4] = {gb2.x, gb2.y, gb2.z, gb2.w}, u2[4] = {ub.x, ub.y, ub.z, ub.w};
#pragma unroll
                for (int e = 0; e < 4; ++e) { cm2[2 * e] = bflo(g1[e]) * bflo(u1[e]); cm2[2 * e + 1] = bfhi(g1[e]) * bfhi(u1[e]); cm1[2 * e] = bflo(g2[e]) * bflo(u2[e]); cm1[2 * e + 1] = bfhi(g2[e]) * bfhi(u2[e]); }
            }
#pragma unroll
            for (int rr = 0; rr < 8; ++rr) {
                const bf16* zr = Z + (size_t)(r0 + rr) * NZ;
                const u32x4 gbv = *(const u32x4*)(zr + 2048 + c0), gcv = *(const u32x4*)(zr + 2560 + c0), uv = *(const u32x4*)(zr + 3072 + c0);
                const unsigned gb_[4] = {gbv.x, gbv.y, gbv.z, gbv.w}, gc_[4] = {gcv.x, gcv.y, gcv.z, gcv.w}, u_[4] = {uv.x, uv.y, uv.z, uv.w};
                float y[8];
#pragma unroll
                for (int e = 0; e < 4; ++e) {
                    const float cu0 = bflo(gc_[e]) * bflo(u_[e]), cu1 = bfhi(gc_[e]) * bfhi(u_[e]);
                    y[2 * e] = bflo(gb_[e]) * (w0[2 * e] * cm2[2 * e] + w1[2 * e] * cm1[2 * e] + w2[2 * e] * cu0);
                    y[2 * e + 1] = bfhi(gb_[e]) * (w0[2 * e + 1] * cm2[2 * e + 1] + w1[2 * e + 1] * cm1[2 * e + 1] + w2[2 * e + 1] * cu1);
                    cm2[2 * e] = cm1[2 * e]; cm2[2 * e + 1] = cm1[2 * e + 1]; cm1[2 * e] = cu0; cm1[2 * e + 1] = cu1;
                }
                u32x4 o; o.x = cvt_pk_bf16(y[0], y[1]); o.y = cvt_pk_bf16(y[2], y[3]); o.z = cvt_pk_bf16(y[4], y[5]); o.w = cvt_pk_bf16(y[6], y[7]);
                *(u32x4*)(MIX + (size_t)(r0 + rr) * D + 512 + c0) = o;
            }
            if (t0 + 8 == SEQ) {
                float* pc = P.out + OUT_PCONV + (size_t)(r0 / SEQ) * 1024 + c0;
                *(f32x4*)pc = (f32x4){cm2[0], cm2[1], cm2[2], cm2[3]}; *(f32x4*)(pc + 4) = (f32x4){cm2[4], cm2[5], cm2[6], cm2[7]};
                *(f32x4*)(pc + 512) = (f32x4){cm1[0], cm1[1], cm1[2], cm1[3]}; *(f32x4*)(pc + 516) = (f32x4){cm1[4], cm1[5], cm1[6], cm1[7]};
            }
        }
        const float* sconv = P.in[5];
        for (int i = gw; i < MS; i += NGW) {
            const bf16* zr = Z + (size_t)(MP + i) * NZ;
            const u32x4 gbv = *(const u32x4*)(zr + 2048 + c0), gcv = *(const u32x4*)(zr + 2560 + c0), uv = *(const u32x4*)(zr + 3072 + c0);
            const unsigned gb_[4] = {gbv.x, gbv.y, gbv.z, gbv.w}, gc_[4] = {gcv.x, gcv.y, gcv.z, gcv.w}, u_[4] = {uv.x, uv.y, uv.z, uv.w};
            const float* s0p = sconv + (size_t)i * 1024 + c0;
            const f32x4 s0a = *(const f32x4*)s0p, s0b = *(const f32x4*)(s0p + 4), s1a = *(const f32x4*)(s0p + 512), s1b = *(const f32x4*)(s0p + 516);
            const float s0[8] = {s0a.x, s0a.y, s0a.z, s0a.w, s0b.x, s0b.y, s0b.z, s0b.w}, s1[8] = {s1a.x, s1a.y, s1a.z, s1a.w, s1b.x, s1b.y, s1b.z, s1b.w};
            float y[8], cu[8];
#pragma unroll
            for (int e = 0; e < 4; ++e) {
                cu[2 * e] = bflo(gc_[e]) * bflo(u_[e]); cu[2 * e + 1] = bfhi(gc_[e]) * bfhi(u_[e]);
                y[2 * e] = bflo(gb_[e]) * (w0[2 * e] * s0[2 * e] + w1[2 * e] * s1[2 * e] + w2[2 * e] * cu[2 * e]);
                y[2 * e + 1] = bfhi(gb_[e]) * (w0[2 * e + 1] * s0[2 * e + 1] + w1[2 * e + 1] * s1[2 * e + 1] + w2[2 * e + 1] * cu[2 * e + 1]);
            }
            u32x4 o; o.x = cvt_pk_bf16(y[0], y[1]); o.y = cvt_pk_bf16(y[2], y[3]); o.z = cvt_pk_bf16(y[4], y[5]); o.w = cvt_pk_bf16(y[6], y[7]);
            *(u32x4*)(MIX + (size_t)(MP + i) * D + 512 + c0) = o;
            float* sc = P.out + OUT_SCONV + (size_t)i * 1024 + c0;
            *(f32x4*)sc = s1a; *(f32x4*)(sc + 4) = s1b;
            *(f32x4*)(sc + 512) = (f32x4){cu[0], cu[1], cu[2], cu[3]}; *(f32x4*)(sc + 516) = (f32x4){cu[4], cu[5], cu[6], cu[7]};
        }
    }
    {
        LAS float* sq = (LAS float*)lds; LAS float* sk = sq + 128; LAS float* sv = sk + 128; LAS float* sn = sv + 128; LAS float* red = sn + 128;
        const float* C0 = P.in[2]; const float* N0 = P.in[3]; const float* M0 = P.in[4];
        const float* mhn = P.in[12];
        for (int item = wg; item < MS * NH; item += nwg) {
            const int i = item >> 2, h = item & 3, row = MP + i;
            const bf16* zr = Z + (size_t)row * NZ + h * HD;
            if (tid < 128) { sq[tid] = bf2f(zr[tid]); sk[tid] = bf2f(zr[512 + tid]); sv[tid] = bf2f(zr[1024 + tid]); sn[tid] = N0[(size_t)item * 128 + tid]; }
            const float ig = GATES[(size_t)row * 8 + h], lf = GATES[(size_t)row * 8 + 4 + h], m0 = M0[item];
            const float mt = fmaxf(lf + m0, ig), dsc = __expf(ig - mt), decay = __expf(lf + m0 - mt);
            __syncthreads();
            const float qk = wave_sum(sq[lane] * sk[lane] + sq[lane + 64] * sk[lane + 64]);
            const float qn = wave_sum(sq[lane] * sn[lane] + sq[lane + 64] * sn[lane + 64]);
            const int c4 = tid & 31, kr = tid >> 5;
            const f32x4 v4 = *(const LAS f32x4*)(sv + c4 * 4);
            const float* cp = C0 + (size_t)item * 16384 + c4 * 4; float* co = P.out + OUT_SC + (size_t)item * 16384 + c4 * 4;
            f32x4 part = {0.f, 0.f, 0.f, 0.f};
#pragma unroll
            for (int j = 0; j < 8; ++j) { const int dk = kr + 16 * j; const f32x4 cv = *(const f32x4*)(cp + (size_t)dk * 128);
                part += cv * sq[dk]; *(f32x4*)(co + (size_t)dk * 128) = cv * decay + v4 * (dsc * sk[dk]); }
            *(LAS f32x4*)(red + kr * 128 + c4 * 4) = part;
            if (tid < 128) P.out[OUT_SN + (size_t)item * 128 + tid] = decay * sn[tid] + dsc * sk[tid];
            if (tid == 0) P.out[OUT_SM + item] = mt;
            __syncthreads();
            if (wave == 0) {
                float qc0 = 0.f, qc1 = 0.f;
#pragma unroll
                for (int j = 0; j < 16; ++j) { qc0 += red[j * 128 + lane]; qc1 += red[j * 128 + lane + 64]; }
                const float scores = qk * dsc, den = scores + decay * qn, dn = fmaxf(fabsf(den), __expf(-mt));
                const float h0 = (scores * sv[lane] + decay * qc0) / dn, h1 = (scores * sv[lane + 64] + decay * qc1) / dn;
                const float rn = rsqrtf(wave_sum(h0 * h0 + h1 * h1) * (1.f / HD) + EPS);
                const float o0 = h0 * rn * mhn[h * HD + lane] * sigmoidf_(bf2f(zr[1536 + lane])), o1 = h1 * rn * mhn[h * HD + lane + 64] * sigmoidf_(bf2f(zr[1536 + lane + 64]));
                MIX[(size_t)row * D + h * HD + lane] = (bf16)f2bf(o0); MIX[(size_t)row * D + h * HD + lane + 64] = (bf16)f2bf(o1);
            }
            __syncthreads();
        }
    }
}

__device__ __forceinline__ void phase2b(const Params& P, int wg, int nwg) {
    const int tid = threadIdx.x;
    unsigned char* ws = P.ws;
    const float* BL = (const float*)(ws + WS_SMALL); const float* AMAX = BL + 1024; float* MPREV = (float*)(ws + WS_SMALL) + 2048;
    const float* U = P.out; const float* UN = (const float*)(ws + WS_UN); float* NPREV = (float*)(ws + WS_NPREV);
    bf16* CP = (bf16*)(ws + WS_H1);
    for (int id = wg; id < 256; id += nwg) {
        const int bh = id >> 3, part = id & 7, e = part * 2048 + tid * 4;
        const bool don = (part == 0 && tid < 128);
        f32x4 C = {0.f, 0.f, 0.f, 0.f}; float n = 0.f, m = M_INIT;
#pragma unroll 4
        for (int c = 0; c < NCH; ++c) {
            const int it = bh * NCH + c;
            const float bl = BL[it], am = AMAX[it];
            const float mn = bl + fmaxf(m, am), al = __expf(bl + m - mn), be = __expf(bl + am - mn);
            u32x2 o; o.x = cvt_pk_bf16(C[0], C[1]); o.y = cvt_pk_bf16(C[2], C[3]);
            *(u32x2*)(CP + (size_t)it * 16384 + e) = o;
            const f32x4 u = *(const f32x4*)(U + (size_t)it * 16384 + e);
            C = C * al + u * be;
            if (don) { NPREV[(size_t)it * 128 + tid] = n; n = al * n + be * UN[(size_t)it * 128 + tid]; }
            if (part == 0 && tid == 0) MPREV[it] = m;
            m = mn;
        }
        const int dv = e >> 7, dk = e & 127;
        float* pc = P.out + OUT_PC + (size_t)bh * 16384 + dv;
#pragma unroll
        for (int j = 0; j < 4; ++j) pc[(size_t)(dk + j) * 128] = C[j];
        if (don) P.out[OUT_PN + bh * 128 + tid] = n;
        if (part == 0 && tid == 0) P.out[OUT_PM + bh] = m;
    }
}

__device__ __forceinline__ void phase2c(const Params& P, LAS unsigned char* lds, int wg, int nwg) {
    const int tid = threadIdx.x, lane = tid & 63, wave = tid >> 6, fr = lane & 15, fq = lane >> 4;
    unsigned char* ws = P.ws;
    const bf16* Z = (const bf16*)(ws + WS_Z); const float* GATES = (const float*)(ws + WS_GATES);
    bf16* MIX = (bf16*)(ws + WS_MIX);
    const float* MPREV = (const float*)(ws + WS_SMALL) + 2048; const float* NPREV = (const float*)(ws + WS_NPREV);
    const bf16* CP = (const bf16*)(ws + WS_H1);
    const float* mhn = P.in[12];
    LAS bf16* Vt = (LAS bf16*)lds;
    LAS bf16* Pm = Vt + 128 * TS;
    LAS float* sa = (LAS float*)(lds + (128 + 64) * TS * 2); LAS float* sg = sa + 64; LAS float* sdec = sg + 64; LAS float* seinv = sdec + 64;
    LAS float* denp = seinv + 64;
    LAS float* sqn = denp + 256;
    LAS float* sss = sqn + 64;
    for (int item = wg; item < NITEM; item += nwg) {
        const int b = item >> 7, h = (item >> 5) & 3, c = item & 31, r0 = b * SEQ + c * CH;
        if (wave == 0) {
            const float lf = GATES[(size_t)(r0 + lane) * 8 + 4 + h], ig = GATES[(size_t)(r0 + lane) * 8 + h];
            const float bc = scan_add(lf, lane), a = ig - bc, mx = scan_max(a, lane), mp = MPREV[item];
            const float g = fmaxf(mp, mx), mt = bc + g;
            sa[lane] = a; sg[lane] = g; sdec[lane] = __expf(mp - g); seinv[lane] = __expf(-mt);
        }
        {
            const int s = tid >> 3, seg = tid & 7;
            const bf16* zr = Z + (size_t)(r0 + s) * NZ + 1024 + h * HD + seg * 16;
            const u32x4 v0 = *(const u32x4*)zr, v1 = *(const u32x4*)(zr + 8);
            const unsigned vv[8] = {v0.x, v0.y, v0.z, v0.w, v1.x, v1.y, v1.z, v1.w};
#pragma unroll
            for (int e = 0; e < 8; ++e) { const int d = seg * 16 + 2 * e; Vt[d * TS + s] = (bf16)(vv[e] & 0xffffu); Vt[(d + 1) * TS + s] = (bf16)(vv[e] >> 16); }
        }
        const int tt = wave & 3, hh = wave >> 2, t = tt * 16 + fr;
        bf16x8 qf[4];
        {
            const bf16* qp = Z + (size_t)(r0 + t) * NZ + h * HD + fq * 8;
#pragma unroll
            for (int ks = 0; ks < 4; ++ks) qf[ks] = *(const bf16x8*)(qp + ks * 32);
        }
        __syncthreads();
#pragma unroll
        for (int si = 0; si < 2; ++si) {
            const int st = hh * 2 + si;
            f32x4 acc = {0.f, 0.f, 0.f, 0.f};
            if (st <= tt) {
                const bf16* kp = Z + (size_t)(r0 + st * 16 + fr) * NZ + 512 + h * HD + fq * 8;
#pragma unroll
                for (int ks = 0; ks < 4; ++ks) { const bf16x8 kf = *(const bf16x8*)(kp + ks * 32); acc = __builtin_amdgcn_mfma_f32_16x16x32_bf16(kf, qf[ks], acc, 0, 0, 0); }
            }
            const float gt = sg[t];
            float p[4]; float ps = 0.f;
#pragma unroll
            for (int r = 0; r < 4; ++r) { const int s = st * 16 + fq * 4 + r; const float e = __expf(sa[s] - gt); p[r] = (s <= t) ? acc[r] * e : 0.f; ps += p[r]; }
            u32x2 o; o.x = cvt_pk_bf16(p[0], p[1]); o.y = cvt_pk_bf16(p[2], p[3]);
            *(LAS u32x2*)(Pm + t * TS + st * 16 + fq * 4) = o;
            ps += __shfl_xor(ps, 16); ps += __shfl_xor(ps, 32);
            if (fq == 0) denp[st * 64 + t] = ps;
        }
        if (hh == 0) {
            const float* np = NPREV + (size_t)item * 128 + fq * 8; float s = 0.f;
#pragma unroll
            for (int ks = 0; ks < 4; ++ks) { const f32x4 n0 = *(const f32x4*)(np + ks * 32), n1 = *(const f32x4*)(np + ks * 32 + 4);
                const bf16x8 q = qf[ks];
                s += bf2f((unsigned short)q[0]) * n0.x + bf2f((unsigned short)q[1]) * n0.y + bf2f((unsigned short)q[2]) * n0.z + bf2f((unsigned short)q[3]) * n0.w
                   + bf2f((unsigned short)q[4]) * n1.x + bf2f((unsigned short)q[5]) * n1.y + bf2f((unsigned short)q[6]) * n1.z + bf2f((unsigned short)q[7]) * n1.w; }
            s += __shfl_xor(s, 16); s += __shfl_xor(s, 32);
            if (fq == 0) sqn[t] = s;
        }
        __syncthreads();
        f32x4 a1[4], a2[4];
#pragma unroll
        for (int d = 0; d < 4; ++d) { a1[d] = (f32x4){0.f, 0.f, 0.f, 0.f}; a2[d] = (f32x4){0.f, 0.f, 0.f, 0.f}; }
        {
            const bf16x8 pf0 = *(const LAS bf16x8*)(Pm + t * TS + fq * 8), pf1 = *(const LAS bf16x8*)(Pm + t * TS + 32 + fq * 8);
#pragma unroll
            for (int d = 0; d < 4; ++d) { const int dvr = (hh * 4 + d) * 16 + fr;
                const bf16x8 vf0 = *(const LAS bf16x8*)(Vt + dvr * TS + fq * 8), vf1 = *(const LAS bf16x8*)(Vt + dvr * TS + 32 + fq * 8);
                a1[d] = __builtin_amdgcn_mfma_f32_16x16x32_bf16(vf0, pf0, a1[d], 0, 0, 0);
                a1[d] = __builtin_amdgcn_mfma_f32_16x16x32_bf16(vf1, pf1, a1[d], 0, 0, 0);
                const bf16* cp = CP + (size_t)item * 16384 + (size_t)dvr * 128 + fq * 8;
#pragma unroll
                for (int ks = 0; ks < 4; ++ks) { const bf16x8 cf = *(const bf16x8*)(cp + ks * 32); a2[d] = __builtin_amdgcn_mfma_f32_16x16x32_bf16(cf, qf[ks], a2[d], 0, 0, 0); }
            }
        }
        const float dec = sdec[t];
        const float den = ((denp[t] + denp[64 + t]) + (denp[128 + t] + denp[192 + t])) + dec * sqn[t];
        const float inv = 1.0f / fmaxf(fabsf(den), seinv[t]);
        float ssq = 0.f;
#pragma unroll
        for (int d = 0; d < 4; ++d)
#pragma unroll
            for (int r = 0; r < 4; ++r) { const float hv = (a1[d][r] + dec * a2[d][r]) * inv; a1[d][r] = hv; ssq += hv * hv; }
        ssq += __shfl_xor(ssq, 16); ssq += __shfl_xor(ssq, 32);
        if (fq == 0) sss[hh * 64 + t] = ssq;
        __syncthreads();
        const float rn = rsqrtf((sss[t] + sss[64 + t]) * (1.f / HD) + EPS);
        const size_t row = (size_t)(r0 + t);
#pragma unroll
        for (int d = 0; d < 4; ++d) {
            const int col = h * HD + (hh * 4 + d) * 16 + fq * 4;
            const f32x4 mw = *(const f32x4*)(mhn + col);
            const u32x2 ogw = *(const u32x2*)(Z + row * NZ + 1536 + col);
            const float o0 = a1[d][0] * rn * mw.x * sigmoidf_(bflo(ogw.x)), o1 = a1[d][1] * rn * mw.y * sigmoidf_(bfhi(ogw.x));
            const float o2 = a1[d][2] * rn * mw.z * sigmoidf_(bflo(ogw.y)), o3 = a1[d][3] * rn * mw.w * sigmoidf_(bfhi(ogw.y));
            u32x2 o; o.x = cvt_pk_bf16(o0, o1); o.y = cvt_pk_bf16(o2, o3);
            *(u32x2*)(MIX + row * D + col) = o;
        }
        __syncthreads();
    }
}

__device__ __forceinline__ void phase7(const Params& P, int wg, int nwg) {
    const int tid = threadIdx.x, lane = tid & 63, wave = tid >> 6;
    const float* g = P.in[21];
    f32x4 gv[4];
#pragma unroll
    for (int j = 0; j < 4; ++j) gv[j] = *(const f32x4*)(g + 4 * lane + 256 * j);
    for (int m = wg * 8 + wave; m < MT; m += nwg * 8) {
        float* xr = P.out + (size_t)m * D + 4 * lane;
        f32x4 v[4]; float s = 0.f;
#pragma unroll
        for (int j = 0; j < 4; ++j) { v[j] = *(const f32x4*)(xr + 256 * j); s += (v[j].x * v[j].x + v[j].y * v[j].y) + (v[j].z * v[j].z + v[j].w * v[j].w); }
        const float r = rsqrtf(wave_sum(s) * (1.f / D) + EPS);
#pragma unroll
        for (int j = 0; j < 4; ++j) *(f32x4*)(xr + 256 * j) = v[j] * r * gv[j];
    }
}

__global__ void __launch_bounds__(512, 2) mk_fwd(Params P) {
    extern __shared__ __attribute__((aligned(16))) unsigned char lds_raw[];
    LAS unsigned char* lds = (LAS unsigned char*)lds_raw;
    cg::grid_group grid = cg::this_grid();
    const int wg = blockIdx.x, nwg = gridDim.x;
    unsigned char* ws = P.ws;
    const int lo = P.ph_lo, hi = P.ph_hi;
#ifndef PHMASK
#define PHMASK 0x3ff
#endif
#define IN(k) (((PHMASK >> (k)) & 1) && lo <= (k) && (k) < hi)
#define SEAM(k) do { if (IN(k) && IN((k) + 1)) { asm volatile("s_waitcnt vmcnt(0) lgkmcnt(0)" ::: "memory"); __builtin_amdgcn_fence(__ATOMIC_RELEASE, "agent"); asm volatile("s_waitcnt vmcnt(0)" ::: "memory"); grid.sync(); \
    if (threadIdx.x < 64) { __builtin_amdgcn_fence(__ATOMIC_ACQUIRE, "agent"); asm volatile("s_waitcnt vmcnt(0)" ::: "memory"); } __syncthreads(); } } while (0)
    LAS float* red = (LAS float*)(lds + LDS_RED);
    bf16* H1 = (bf16*)(ws + WS_H1); bf16* Zb = (bf16*)(ws + WS_Z); bf16* PP = (bf16*)(ws + WS_PP); bf16* PB = (bf16*)(ws + WS_PB);
    bf16* MIX = (bf16*)(ws + WS_MIX); bf16* HF = (bf16*)(ws + WS_HF);
    float* SSP1 = (float*)(ws + WS_SSP1); float* SSP2 = (float*)(ws + WS_SSP2);
    float* SSS1 = (float*)(ws + WS_SMALL) + 4096; float* SSS2 = SSS1 + 128 * 64;
    float* XR = P.out;

    if (IN(0)) { phase0(P, lds, wg, nwg); }
    SEAM(0);
    if (IN(1)) {
        small_gemm<1>(H1 + (size_t)MP * D, (const bf16*)(ws + WS_W1T), NZ, D, red, wg, nwg,
            [&](int row, int col, const f32x4& v) { u32x2 o; o.x = cvt_pk_bf16(v[0], v[1]); o.y = cvt_pk_bf16(v[2], v[3]); *(u32x2*)(Zb + (size_t)(MP + row) * NZ + col) = o; });
        small_gemm<1>(PB + (size_t)MP * PLE, (const bf16*)(ws + WS_WPT), D, PLE, red, wg, nwg,
            [&](int row, int col, const f32x4& v) { u32x2 o; o.x = cvt_pk_bf16(v[0], v[1]); o.y = cvt_pk_bf16(v[2], v[3]); *(u32x2*)(PP + (size_t)(MP + row) * D + col) = o; });
        { pg8::Gemm g{H1, (const bf16*)(ws + WS_W1T), MP, NZ, D}; pg8::StaticOrder S; S.init(MP, NZ, nwg, wg); EpiStoreBf16 E{Zb, NZ};
          pg8::gemm_phase<EpiStoreBf16, pg8::StaticOrder, true, true>(lds, g, S, E); }
        { pg8::Gemm g{PB, (const bf16*)(ws + WS_WPT), MP, D, PLE}; UpperHalfOrder S{nwg, wg, MP / 256, D / 256}; EpiStoreBf16 E{PP, D};
          pg8::gemm_phase<EpiStoreBf16, UpperHalfOrder, false, true>(lds, g, S, E); }
    }
    SEAM(1);
    if (IN(2)) { phase2a(P, lds, wg, nwg); }
    SEAM(2);
    if (IN(3)) { phase2b(P, wg, nwg); }
    SEAM(3);
    if (IN(4)) { phase2c(P, lds, wg, nwg); }
    SEAM(4);
    if (IN(5)) {
        const float* xs = P.in[1];
        small_gemm<4>(MIX + (size_t)MP * D, (const bf16*)(ws + WS_WOT), D, D, red, wg, nwg,
            [&](int row, int col, const f32x4& v) { const size_t off = (size_t)(MP + row) * D + col; const f32x4 x = *(const f32x4*)(xs + (size_t)row * D + col) + v;
                *(f32x4*)(XR + off) = x; u32x2 o; o.x = cvt_pk_bf16(x[0], x[1]); o.y = cvt_pk_bf16(x[2], x[3]); *(u32x2*)(H1 + off) = o;
                float ss = (x[0] * x[0] + x[1] * x[1]) + (x[2] * x[2] + x[3] * x[3]); ss += __shfl_xor(ss, 16); ss += __shfl_xor(ss, 32);
                if ((threadIdx.x & 63) < 16) SSS1[row * 64 + (col >> 4)] = ss; });
        pg8::Gemm g{MIX, (const bf16*)(ws + WS_WOT), MP, D, D}; pg8::StaticOrder S; S.init(MP, D, nwg, wg); EpiRes E{P.in[0], XR, H1, SSP1};
        pg8::gemm_phase<EpiRes, pg8::StaticOrder, true, true>(lds, g, S, E);
    }
    SEAM(5);
    if (IN(6)) {
        small_gemm<1>(H1 + (size_t)MP * D, (const bf16*)(ws + WS_WUPT), FF, D, red, wg, nwg,
            [&](int row, int col, const f32x4& v) { const float r = row_rs64(SSS1, row); float a[4];
#pragma unroll
                for (int e = 0; e < 4; ++e) { const float t = fmaxf(v[e] * r, 0.f); a[e] = t * t; }
                u32x2 o; o.x = cvt_pk_bf16(a[0], a[1]); o.y = cvt_pk_bf16(a[2], a[3]); *(u32x2*)(HF + (size_t)(MP + row) * FF + col) = o; });
        pg8::Gemm g{H1, (const bf16*)(ws + WS_WUPT), MP, FF, D}; pg8::StaticOrder S; S.init(MP, FF, nwg, wg); EpiUp E{HF, SSP1};
        pg8::gemm_phase<EpiUp, pg8::StaticOrder, true, true>(lds, g, S, E);
    }
    SEAM(6);
    if (IN(7)) {
        small_gemm<8>(HF + (size_t)MP * FF, (const bf16*)(ws + WS_WDNT), D, FF, red, wg, nwg,
            [&](int row, int col, const f32x4& v) { const size_t off = (size_t)(MP + row) * D + col; const f32x4 x = *(const f32x4*)(XR + off) + v;
                *(f32x4*)(XR + off) = x; u32x2 o; o.x = cvt_pk_bf16(x[0], x[1]); o.y = cvt_pk_bf16(x[2], x[3]); *(u32x2*)(H1 + off) = o;
                float ss = (x[0] * x[0] + x[1] * x[1]) + (x[2] * x[2] + x[3] * x[3]); ss += __shfl_xor(ss, 16); ss += __shfl_xor(ss, 32);
                if ((threadIdx.x & 63) < 16) SSS2[row * 64 + (col >> 4)] = ss; });
        pg8::Gemm g{HF, (const bf16*)(ws + WS_WDNT), MP, D, FF}; pg8::StaticOrder S; S.init(MP, D, nwg, wg); EpiRes E{XR, XR, H1, SSP2};
        pg8::gemm_phase<EpiRes, pg8::StaticOrder, true, true>(lds, g, S, E);
    }
    SEAM(7);
    if (IN(8)) {
        small_gemm<4>(H1 + (size_t)MP * D, (const bf16*)(ws + WS_WGT), D, D, red, wg, nwg,
            [&](int row, int col, const f32x4& v) { const size_t off = (size_t)(MP + row) * D + col; const float r = row_rs64(SSS2, row);
                const u32x2 pw = *(const u32x2*)(PP + off); f32x4 x = *(const f32x4*)(XR + off);
                x[0] += sigmoidf_(v[0] * r) * bflo(pw.x); x[1] += sigmoidf_(v[1] * r) * bfhi(pw.x); x[2] += sigmoidf_(v[2] * r) * bflo(pw.y); x[3] += sigmoidf_(v[3] * r) * bfhi(pw.y);
                *(f32x4*)(XR + off) = x; });
        pg8::Gemm g{H1, (const bf16*)(ws + WS_WGT), MP, D, D}; pg8::StaticOrder S; S.init(MP, D, nwg, wg); EpiPle E{XR, PP, SSP2};
        pg8::gemm_phase<EpiPle, pg8::StaticOrder, true, true>(lds, g, S, E);
    }
    SEAM(8);
    if (IN(9)) { phase7(P, wg, nwg); }
#undef IN
#undef SEAM
}

extern "C" void kernel_launch(void* const* d_in, const int* in_sizes, int n_in, void* d_out, int out_size, void* d_ws, size_t ws_size, hipStream_t stream) {
    static int grid = 0;
    if (grid == 0) {
        if (n_in != 22 || (size_t)out_size != OUT_END || ws_size < WS_END) { fprintf(stderr, "kernel_launch: unexpected shapes: n_in %d out %d ws %zu\n", n_in, out_size, ws_size); grid = -1; return; }
        int dev = 0, cus = 0, per_cu = 0;
        if (hipGetDevice(&dev) != hipSuccess || hipDeviceGetAttribute(&cus, hipDeviceAttributeMultiprocessorCount, dev) != hipSuccess) { grid = -1; return; }
        if (hipFuncSetAttribute((const void*)mk_fwd, hipFuncAttributeMaxDynamicSharedMemorySize, LDS_BYTES) != hipSuccess) { fprintf(stderr, "kernel_launch: hipFuncSetAttribute failed\n"); grid = -1; return; }
        if (hipOccupancyMaxActiveBlocksPerMultiprocessor(&per_cu, (const void*)mk_fwd, 512, LDS_BYTES) != hipSuccess || per_cu < 1) { fprintf(stderr, "kernel_launch: occupancy query says %d\n", per_cu); per_cu = 1; }
        (void)hipGetLastError();
        grid = cus;
    }
    if (grid < 0) return;
    Params p{};
    for (int i = 0; i < 22; ++i) p.in[i] = (const float*)d_in[i];
    p.out = (float*)d_out; p.ws = (unsigned char*)d_ws;
#if MK_PER_PHASE
    for (int ph = 0; ph < 10; ++ph) { p.ph_lo = ph; p.ph_hi = ph + 1; hipLaunchKernelGGL(mk_fwd, dim3(grid), dim3(512), LDS_BYTES, stream, p); }
#else
    p.ph_lo = 0; p.ph_hi = 10;
    void* args[] = {&p};
    hipError_t e = hipLaunchCooperativeKernel((const void*)mk_fwd, dim3(grid), dim3(512), args, LDS_BYTES, stream);
    if (e != hipSuccess) fprintf(stderr, "kernel_launch: cooperative launch failed: %s (grid %d)\n", hipGetErrorString(e), grid);
#endif
}
```

```cpp
#include <hip/hip_runtime.h>
#include <hip/hip_cooperative_groups.h>
#include <cstdio>
#include <cstdint>
namespace cg = cooperative_groups;
namespace pg8 {
#define PG8_LAS __attribute__((address_space(3)))
typedef unsigned short bf16_t;
typedef short bf16x8 __attribute__((ext_vector_type(8)));
typedef float f32x4 __attribute__((ext_vector_type(4)));
typedef unsigned u32x4 __attribute__((ext_vector_type(4)));
constexpr int BM = 256, BK = 64, HALF = 128, HTB = HALF * BK * 2  , STAGE_BYTES = 8 * HTB, NXCD = 8, WGM = 8;

__host__ __device__ __forceinline__ int lds_byte(int r, int c) { const int st = (r >> 4) * 2 + (c >> 5), rr = r & 15, cc = c & 31, ob = rr * 64 + cc * 2; return st * 1024 + (ob ^ (((ob >> 9) & 1) << 5)); }
__host__ __device__ __forceinline__ void stage_rc(int b, int& R, int& C) { const int st = b / 1024, sb = b % 1024, swz = sb ^ (((sb >> 9) & 1) << 5); R = (st >> 1) * 16 + swz / 64; C = (st & 1) * 32 + (swz % 64) / 2; }
__host__ __device__ __forceinline__ int perm32(int rho) { const int n = rho >> 4, i = rho & 15; return 8 * (i >> 2) + 4 * n + (i & 3); }

struct Unit { int pm, pn; };
struct Gemm { const bf16_t* A; const bf16_t* Bt; int M, N, K; };

struct StaticOrder {
    int nM, nN, nwg, G, c;
    __host__ __device__ void init(int M, int N, int G_, int c_) { nM = M / BM; nN = N / BM; nwg = nM * nN; G = G_; c = c_; }
    __host__ __device__ bool next(int i, Unit& u) const {
        const long L = (long)i * G + c; if (L >= nwg) return false;
        int wgid = (int)L; { const int q = nwg / NXCD, r = nwg % NXCD, xcd = wgid % NXCD, off = wgid / NXCD; wgid = (xcd < r ? xcd * (q + 1) : r * (q + 1) + (xcd - r) * q) + off; }
        const int nig = WGM * nN, gid = wgid / nig, fm = gid * WGM, gsz = (nM - fm) < WGM ? (nM - fm) : WGM;
        u.pm = fm + ((wgid % nig) % gsz); u.pn = (wgid % nig) / gsz; return true;
    }
    __device__ __forceinline__ void a_ready(const Unit&) const {}
    __device__ __forceinline__ void done(const Unit&) const {}
};

__device__ __forceinline__ unsigned cvt_pk_bf16(float lo, float hi) { unsigned r; asm volatile("v_cvt_pk_bf16_f32 %0, %1, %2" : "=v"(r) : "v"(lo), "v"(hi)); return r; }
template <class Epi, class Sched, bool ALIGN_EPI = false, bool SP2 = false>
__device__ __forceinline__ void gemm_phase(PG8_LAS unsigned char* lds, const Gemm g, const Sched& S, const Epi& E) {
    const int tid = threadIdx.x, wid = __builtin_amdgcn_readfirstlane(tid >> 6), lane = tid & 63, wr = wid >> 2, wc = wid & 3, fr = lane & 15, fq = lane >> 4;
    const int K = g.K, nt = K / BK;
    unsigned voffA[2], voffB[2];
#pragma unroll
    for (int i = 0; i < 2; ++i) { int R, C; stage_rc(tid * 16 + i * 8192, R, C); const int Rb = Epi::PERM ? ((R & ~31) + perm32(R & 31)) : R;
        voffA[i] = (unsigned)(R * K + C) * 2u; voffB[i] = (unsigned)(Rb * K + C) * 2u; }
    const size_t kstep = (size_t)(BK * 2);
    const size_t hstep = (size_t)HALF * K * 2;
    const size_t tstep = 2 * hstep;
    const unsigned ldsw = (unsigned)wid * 1024u;
    const int aoff = lds_byte(wr * 64 + fr, fq * 8), boff = lds_byte(wc * 32 + fr, fq * 8);
#define PG8_SA(b, h) (((b) * 2 + (h)) * HTB)
#define PG8_SB(b, h) ((4 + (b) * 2 + (h)) * HTB)
#define PG8_STAGE(bufoff, gbase, voff) do { _Pragma("unroll") for (int _i = 0; _i < 2; ++_i) \
        __builtin_amdgcn_global_load_lds((const unsigned*)((const char*)(gbase) + (voff)[_i]), (PG8_LAS unsigned*)(lds + (bufoff) + ldsw + _i * 8192), 16, 0, 0); } while (0)
#define PG8_LDA(dst, b, h) do { _Pragma("unroll") for (int m = 0; m < 4; ++m) _Pragma("unroll") for (int k = 0; k < 2; ++k) dst[m][k] = *(const PG8_LAS bf16x8*)(lds + PG8_SA(b, h) + aoff + m * 2048 + k * 1024); } while (0)
#define PG8_LDB(dst, b, h) do { _Pragma("unroll") for (int n = 0; n < 2; ++n) _Pragma("unroll") for (int k = 0; k < 2; ++k) dst[n][k] = *(const PG8_LAS bf16x8*)(lds + PG8_SB(b, h) + boff + n * 2048 + k * 1024); } while (0)
#define PG8_MMA(ai, bj, At, Bt) do { __builtin_amdgcn_s_setprio(1); _Pragma("unroll") for (int m = 0; m < 4; ++m) _Pragma("unroll") for (int n = 0; n < 2; ++n) _Pragma("unroll") for (int k = 0; k < 2; ++k) \
        acc[ai][bj][m][n] = __builtin_amdgcn_mfma_f32_16x16x32_bf16(Bt[n][k], At[m][k], acc[ai][bj][m][n], 0, 0, 0); __builtin_amdgcn_s_setprio(0); } while (0)
#define PG8_WAIT_V(n) asm volatile("s_waitcnt vmcnt(" #n ")" ::: "memory")
#define PG8_WAIT_L(n) asm volatile("s_waitcnt lgkmcnt(" #n ")" ::: "memory")
#define PG8_BAR __builtin_amdgcn_s_barrier()
#define PG8_SCHED __builtin_amdgcn_sched_barrier(0)
    Unit cur, nxt; int ui = 0;
    if (!S.next(0, cur)) return;
    f32x4 acc[2][2][4][2];
#pragma unroll
    for (int a = 0; a < 2; ++a)
#pragma unroll
        for (int b = 0; b < 2; ++b)
#pragma unroll
            for (int m = 0; m < 4; ++m)
#pragma unroll
                for (int n = 0; n < 2; ++n) acc[a][b][m][n] = (f32x4){0.f, 0.f, 0.f, 0.f};
    bf16x8 At[4][2], B0[2][2], B1[2][2];
    const char* cA = (const char*)g.A + (size_t)cur.pm * tstep; const char* cB = (const char*)g.Bt + (size_t)cur.pn * tstep;
    S.a_ready(cur);
    if constexpr (SP2) {
        PG8_STAGE(PG8_SB(0, 0), cB, voffB); PG8_STAGE(PG8_SB(0, 1), cB + hstep, voffB); PG8_STAGE(PG8_SA(0, 0), cA, voffA); PG8_STAGE(PG8_SA(0, 1), cA + hstep, voffA);
        if (wr == 1) PG8_BAR;
        PG8_WAIT_V(2); PG8_BAR;
        PG8_STAGE(PG8_SB(1, 0), cB + kstep, voffB); PG8_STAGE(PG8_SA(1, 0), cA + kstep, voffA); PG8_STAGE(PG8_SB(1, 1), cB + hstep + kstep, voffB);
        PG8_WAIT_V(6); PG8_BAR;
    } else {
        PG8_STAGE(PG8_SB(0, 0), cB, voffB); PG8_STAGE(PG8_SA(0, 0), cA, voffA); PG8_STAGE(PG8_SB(0, 1), cB + hstep, voffB); PG8_STAGE(PG8_SA(0, 1), cA + hstep, voffA);
        if (wr == 1) PG8_BAR;
        PG8_WAIT_V(4); PG8_BAR;
        PG8_STAGE(PG8_SB(1, 0), cB + kstep, voffB); PG8_STAGE(PG8_SA(1, 0), cA + kstep, voffA); PG8_STAGE(PG8_SB(1, 1), cB + hstep + kstep, voffB);
        PG8_WAIT_V(6); PG8_BAR;
    }
    for (;;) {
        const bool has_next = S.next(ui + 1, nxt);
        const char* nA = has_next ? (const char*)g.A + (size_t)nxt.pm * tstep : cA; const char* nB = has_next ? (const char*)g.Bt + (size_t)nxt.pn * tstep : cB;
        for (int t = 0; t < nt; t += 2) {
            const bool last = (t == nt - 2);
            const char* a1 = cA + (size_t)(t + 1) * kstep;
            const char* a2 = last ? nA : cA + (size_t)(t + 2) * kstep; const char* b2 = last ? nB : cB + (size_t)(t + 2) * kstep;
            const char* a3 = a2 + kstep; const char* b3 = b2 + kstep;
            if (last && has_next) S.a_ready(nxt);
            if constexpr (SP2) {
            PG8_LDB(B0, 0, 0); PG8_LDB(B1, 0, 1); PG8_SCHED; PG8_LDA(At, 0, 0); PG8_STAGE(PG8_SA(1, 1), a1 + hstep, voffA);
            PG8_WAIT_V(8); PG8_WAIT_L(0); PG8_BAR; PG8_MMA(0, 0, At, B0); PG8_MMA(0, 1, At, B1); PG8_BAR; PG8_SCHED;
            PG8_LDA(At, 0, 1); PG8_STAGE(PG8_SB(0, 0), b2, voffB); PG8_STAGE(PG8_SB(0, 1), b2 + hstep, voffB); PG8_STAGE(PG8_SA(0, 0), a2, voffA);
            PG8_WAIT_V(8); PG8_WAIT_L(0); PG8_BAR; PG8_MMA(1, 0, At, B0); PG8_MMA(1, 1, At, B1); PG8_BAR; PG8_SCHED;
            PG8_LDB(B0, 1, 0); PG8_LDB(B1, 1, 1); PG8_SCHED; PG8_LDA(At, 1, 0); PG8_STAGE(PG8_SA(0, 1), a2 + hstep, voffA);
            PG8_WAIT_V(8); PG8_WAIT_L(0); PG8_BAR; PG8_MMA(0, 0, At, B0); PG8_MMA(0, 1, At, B1); PG8_BAR; PG8_SCHED;
            PG8_LDA(At, 1, 1); PG8_STAGE(PG8_SB(1, 0), b3, voffB); PG8_STAGE(PG8_SB(1, 1), b3 + hstep, voffB); PG8_STAGE(PG8_SA(1, 0), a3, voffA);
            PG8_WAIT_V(8); PG8_WAIT_L(0); PG8_BAR; PG8_MMA(1, 0, At, B0); PG8_MMA(1, 1, At, B1); PG8_BAR; PG8_SCHED;
            } else {
            PG8_LDB(B0, 0, 0); PG8_SCHED; PG8_LDA(At, 0, 0); PG8_STAGE(PG8_SA(1, 1), a1 + hstep, voffA);
            PG8_WAIT_L(8); PG8_BAR; PG8_WAIT_L(0); PG8_MMA(0, 0, At, B0); PG8_BAR; PG8_SCHED;
            PG8_LDB(B1, 0, 1); PG8_STAGE(PG8_SB(0, 0), b2, voffB);
            PG8_BAR; PG8_WAIT_L(0); PG8_MMA(0, 1, At, B1); PG8_BAR;
            PG8_LDA(At, 0, 1); PG8_STAGE(PG8_SA(0, 0), a2, voffA);
            PG8_BAR; PG8_WAIT_L(0); PG8_MMA(1, 0, At, B0); PG8_BAR; PG8_SCHED;
            PG8_STAGE(PG8_SB(0, 1), b2 + hstep, voffB);
            PG8_WAIT_V(6); PG8_BAR; PG8_MMA(1, 1, At, B1); PG8_BAR;
            PG8_LDB(B0, 1, 0); PG8_SCHED; PG8_LDA(At, 1, 0); PG8_STAGE(PG8_SA(0, 1), a2 + hstep, voffA);
            PG8_WAIT_L(8); PG8_BAR; PG8_WAIT_L(0); PG8_MMA(0, 0, At, B0); PG8_BAR; PG8_SCHED;
            PG8_LDB(B1, 1, 1); PG8_STAGE(PG8_SB(1, 0), b3, voffB);
            PG8_BAR; PG8_WAIT_L(0); PG8_MMA(0, 1, At, B1); PG8_BAR;
            PG8_LDA(At, 1, 1); PG8_STAGE(PG8_SA(1, 0), a3, voffA);
            PG8_BAR; PG8_WAIT_L(0); PG8_MMA(1, 0, At, B0); PG8_BAR; PG8_SCHED;
            PG8_STAGE(PG8_SB(1, 1), b3 + hstep, voffB);
            PG8_WAIT_V(6); PG8_BAR; PG8_MMA(1, 1, At, B1); PG8_BAR;
            }
        }
        if constexpr (ALIGN_EPI) { if (wr == 0) PG8_BAR; }
        if constexpr (!Epi::AFTER_DRAIN) { E(acc, cur, wr, wc, fr, fq); S.done(cur); }
        if (!has_next) break;
#pragma unroll
        for (int a = 0; a < 2; ++a)
#pragma unroll
            for (int b = 0; b < 2; ++b)
#pragma unroll
                for (int m = 0; m < 4; ++m)
#pragma unroll
                    for (int n = 0; n < 2; ++n) acc[a][b][m][n] = (f32x4){0.f, 0.f, 0.f, 0.f};
        cur = nxt; cA = nA; cB = nB; ++ui;
        if constexpr (ALIGN_EPI) { if (wr == 1) PG8_BAR; }
    }
    PG8_WAIT_V(0);
    if constexpr (!ALIGN_EPI) { if (wr == 0) PG8_BAR; }
    PG8_BAR;
    if constexpr (Epi::AFTER_DRAIN) { E.fused(acc, cur, wr, wc, fr, fq, lds, wid, lane); S.done(cur); }
#undef PG8_SA
#undef PG8_SB
#undef PG8_STAGE
#undef PG8_LDA
#undef PG8_LDB
#undef PG8_MMA
#undef PG8_WAIT_V
#undef PG8_WAIT_L
#undef PG8_BAR
#undef PG8_SCHED
}
}

#ifndef MK_PER_PHASE
#define MK_PER_PHASE 0
#endif

constexpr int D = 1024, SEQ = 2048, NB = 8, MP = NB * SEQ, MS = 128, MT = MP + MS;
constexpr int NIN = 3592, NZ = 3584, FF = 4096, PLE = 256, NH = 4, HD = 128, CH = 64, NCH = SEQ / CH, NITEM = NB * NH * NCH;
constexpr float EPS = 1e-6f, M_INIT = -1e30f;
constexpr size_t OUT_Y = 0, OUT_PC = (size_t)MT * D, OUT_PN = OUT_PC + 524288, OUT_PM = OUT_PN + 4096, OUT_PCONV = OUT_PM + 32,
                 OUT_SC = OUT_PCONV + 8192, OUT_SN = OUT_SC + 8388608, OUT_SM = OUT_SN + 65536, OUT_SCONV = OUT_SM + 512, OUT_END = OUT_SCONV + 131072;
constexpr size_t MiB = 1u << 20;
constexpr size_t WS_SMALL = 0;
constexpr size_t WS_SSP1 = 1 * MiB, WS_SSP2 = 2 * MiB;
constexpr size_t WS_BAR = 3 * MiB;
constexpr size_t WS_GATES = 4 * MiB;
constexpr size_t WS_UN = 5 * MiB, WS_NPREV = 5 * MiB + 512 * 1024;
constexpr size_t WS_W1T = 6 * MiB, WS_WOT = 13 * MiB, WS_WUPT = 15 * MiB, WS_WDNT = 23 * MiB, WS_WGT = 31 * MiB, WS_WPT = 33 * MiB;
constexpr size_t WS_PB = 34 * MiB;
constexpr size_t WS_H1 = 43 * MiB;
constexpr size_t WS_PP = 76 * MiB;
constexpr size_t WS_MIX = 109 * MiB;
constexpr size_t WS_Z = 142 * MiB;
constexpr size_t WS_HF = 109 * MiB;
constexpr size_t WS_END = 255 * MiB;
static_assert(WS_Z + (size_t)MT * NZ * 2 <= WS_END && WS_HF + (size_t)MT * FF * 2 <= WS_END, "ws map");

constexpr int LDS_BYTES = 147456, LDS_RED = 131072;

#define GAS __attribute__((address_space(1)))
#define LAS __attribute__((address_space(3)))
typedef unsigned short bf16;
typedef float f32x4 __attribute__((ext_vector_type(4)));
typedef float f32x2 __attribute__((ext_vector_type(2)));
typedef short bf16x8 __attribute__((ext_vector_type(8)));
typedef unsigned u32x4 __attribute__((ext_vector_type(4)));
typedef unsigned u32x2 __attribute__((ext_vector_type(2)));
typedef __bf16 bf16x2_t __attribute__((ext_vector_type(2)));
__device__ __forceinline__ unsigned cvt_pk_bf16(float lo, float hi) { f32x2 v = {lo, hi}; bf16x2_t r = __builtin_convertvector(v, bf16x2_t); return __builtin_bit_cast(unsigned, r); }

__device__ __forceinline__ float bf2f(unsigned b) { return __uint_as_float(b << 16); }
__device__ __forceinline__ float bflo(unsigned w) { return __uint_as_float(w << 16); }
__device__ __forceinline__ float bfhi(unsigned w) { return __uint_as_float(w & 0xffff0000u); }
__device__ __forceinline__ unsigned f2bf(float f) { unsigned u = __float_as_uint(f); return (u + 0x7fffu + ((u >> 16) & 1u)) >> 16; }
__device__ __forceinline__ float wave_sum(float v) {
#pragma unroll
    for (int o = 1; o < 64; o <<= 1) v += __shfl_xor(v, o);
    return v;
}
__device__ __forceinline__ float wave_max(float v) {
#pragma unroll
    for (int o = 1; o < 64; o <<= 1) v = fmaxf(v, __shfl_xor(v, o));
    return v;
}
__device__ __forceinline__ float sigmoidf_(float x) { return 1.0f / (1.0f + __expf(-x)); }
__device__ __forceinline__ float logsigmoid_(float x) { return fminf(x, 0.f) - log1pf(expf(-fabsf(x))); }

struct Params { const float* in[22]; float* out; unsigned char* ws; int ph_lo, ph_hi; };

#define XB_TMO      128
#define XB_XCNT(j)  (256  + 64 * (j))
#define XB_XSUB(j)  (1280 + 64 * (j))
#define XB_XGEN(j)  (2304 + 64 * (j))
#define XB_TOP      3328
#define XB_TOPGEN   3392
#define XCD_BAR_WORDS 3456
#define XB_SPIN_CAP (1u << 18)

__device__ __forceinline__ unsigned xb_ld(unsigned* p)              { return __hip_atomic_load(p, __ATOMIC_RELAXED, __HIP_MEMORY_SCOPE_AGENT); }
__device__ __forceinline__ unsigned xb_add(unsigned* p, unsigned v) { return __hip_atomic_fetch_add(p, v, __ATOMIC_RELAXED, __HIP_MEMORY_SCOPE_AGENT); }
__device__ __forceinline__ unsigned xb_xcc_id() { return (unsigned)__builtin_amdgcn_s_getreg((3 << 11) | 20) & 0xFu; }
#define XB_SPIN(cond, bar) do { unsigned _sp = 0; while (cond) { __builtin_amdgcn_s_sleep(1); \
    if ((++_sp & 255u) == 0u) { if (xb_ld(&(bar)[XB_TMO])) break; if (_sp > XB_SPIN_CAP) { atomicAdd(&(bar)[XB_TMO], 1u); break; } } } } while (0)

struct XcdBarrier {
    unsigned* bar; unsigned x;
    volatile LAS unsigned* st;
};

__device__ __forceinline__ XcdBarrier xcd_barrier_post(unsigned* bar, volatile LAS unsigned* st) {
    XcdBarrier b; b.bar = bar; b.x = xb_xcc_id(); b.st = st;
    if (threadIdx.x == 0) (void)xb_add(&bar[XB_XCNT(b.x)], 1u);
    return b;
}
__device__ __forceinline__ void xcd_barrier_complete(unsigned* bar, unsigned x, unsigned& nloc, unsigned& nx) {
    const unsigned G = gridDim.x * gridDim.y * gridDim.z;
    unsigned sum, cnt, mine, sp = 0u;
    for (;;) {
        sum = 0u; cnt = 0u; mine = 0u;
#pragma unroll
        for (unsigned j = 0; j < 16; ++j) { const unsigned c = xb_ld(&bar[XB_XCNT(j)]); sum += c; cnt += (c > 0u) ? 1u : 0u; mine = (j == x) ? c : mine; }
        if (sum == G) break;
        __builtin_amdgcn_s_sleep(1);
        if ((++sp & 255u) == 0u) { if (xb_ld(&bar[XB_TMO])) break; if (sp > XB_SPIN_CAP) { atomicAdd(&bar[XB_TMO], 1u); break; } }
    }
    nloc = mine > 0u ? mine : 1u; nx = cnt > 0u ? cnt : 1u;
}

__device__ __forceinline__ void xcd_barrier(const XcdBarrier& b) {
    asm volatile("s_waitcnt vmcnt(0)" ::: "memory");
    __syncthreads();
    if (threadIdx.x == 0) {
        unsigned* bar = b.bar;
        __builtin_amdgcn_s_waitcnt(0);
        unsigned nloc = b.st[0], nx = b.st[1];
        if (nloc == 0u) { xcd_barrier_complete(bar, b.x, nloc, nx); b.st[0] = nloc; b.st[1] = nx; }
        const unsigned old = xb_add(&bar[XB_XSUB(b.x)], 1u);
        const unsigned gen = old / nloc;
        if (old + 1u == (gen + 1u) * nloc) {
            __builtin_amdgcn_fence(__ATOMIC_RELEASE, "agent");
            asm volatile("s_waitcnt vmcnt(0)" ::: "memory");
            const unsigned og = xb_add(&bar[XB_TOP], 1u);
            const unsigned tg = og / nx;
            if (og + 1u == (tg + 1u) * nx) xb_add(&bar[XB_TOPGEN], 1u);
            else XB_SPIN(xb_ld(&bar[XB_TOPGEN]) == tg, bar);
            __builtin_amdgcn_fence(__ATOMIC_ACQUIRE, "agent");
            xb_add(&bar[XB_XGEN(b.x)], 1u);
            asm volatile("s_waitcnt vmcnt(0)" ::: "memory");
        } else {
            XB_SPIN(xb_ld(&bar[XB_XGEN(b.x)]) == gen, bar);
            __builtin_amdgcn_fence(__ATOMIC_ACQUIRE, "agent");
            asm volatile("s_waitcnt vmcnt(0)" ::: "memory");
        }
    }
    __syncthreads();
}

__device__ __forceinline__ void p0_transpose_item(const float* W, int K, int ldw, int c0, int ncols, bf16* WT, int row_off, const float* g, float sc_first512, LAS float* scr, int item, int lane) {
    const int nblk = ncols / 32, kb = item / nblk, nb = item % nblk, k0 = 64 * kb, n0 = 32 * nb;
    const float sc = (n0 < 512) ? sc_first512 : 1.0f;
#pragma unroll 8
    for (int i = 0; i < 32; ++i) { const int kk = 2 * i + (lane >> 5); float v = W[(size_t)(k0 + kk) * ldw + c0 + n0 + (lane & 31)]; if (g) v *= g[k0 + kk]; scr[kk * 33 + (lane & 31)] = v * sc; }
    asm volatile("s_waitcnt lgkmcnt(0)" ::: "memory");
    const int c = lane & 7;
#pragma unroll
    for (int j = 0; j < 4; ++j) { const int n = (lane >> 3) + 8 * j; const LAS float* s = scr + (8 * c) * 33 + n;
        u32x4 o; o.x = cvt_pk_bf16(s[0 * 33], s[1 * 33]); o.y = cvt_pk_bf16(s[2 * 33], s[3 * 33]); o.z = cvt_pk_bf16(s[4 * 33], s[5 * 33]); o.w = cvt_pk_bf16(s[6 * 33], s[7 * 33]);
        *(u32x4*)(WT + (size_t)(row_off + n0 + n) * K + k0 + 8 * c) = o; }
    asm volatile("s_waitcnt lgkmcnt(0)" ::: "memory");
}

__device__ __forceinline__ void phase0(const Params& P, LAS unsigned char* lds, int wg, int nwg) {
    const int tid = threadIdx.x, lane = tid & 63, wave = tid >> 6;
    unsigned char* ws = P.ws;
    LAS float* scr = (LAS float*)(lds + wave * 8704);
    LAS float* wgt = (LAS float*)(lds + 73728);
    const float* w_in = P.in[9];
    for (int i = tid; i < 1024 * 8; i += 512) wgt[i] = w_in[(size_t)(i >> 3) * NIN + 2048 + (i & 7)];
    __syncthreads();
    const int gw = wg * 8 + wave, NGW = nwg * 8;
    {
        const float* g = P.in[8];
        f32x4 gv[4];
#pragma unroll
        for (int j = 0; j < 4; ++j) gv[j] = *(const f32x4*)(g + 4 * lane + 256 * j);
        bf16* H1 = (bf16*)(ws + WS_H1); float* GATES = (float*)(ws + WS_GATES);
        const float* bgi = P.in[10]; const float* bgf = P.in[11];
        for (int m = gw; m < MT; m += NGW) {
            const float* xrow = (m < MP) ? P.in[0] + (size_t)m * D : P.in[1] + (size_t)(m - MP) * D;
            f32x4 v[4]; float s = 0.f;
#pragma unroll
            for (int j = 0; j < 4; ++j) { v[j] = *(const f32x4*)(xrow + 4 * lane + 256 * j); s += (v[j].x * v[j].x + v[j].y * v[j].y) + (v[j].z * v[j].z + v[j].w * v[j].w); }
            const float r = rsqrtf(wave_sum(s) * (1.f / D) + EPS);
            float d0 = 0, d1 = 0, d2 = 0, d3 = 0, d4 = 0, d5 = 0, d6 = 0, d7 = 0;
#pragma unroll
            for (int j = 0; j < 4; ++j) {
                v[j] = v[j] * r * gv[j];
                u32x2 o; o.x = cvt_pk_bf16(v[j].x, v[j].y); o.y = cvt_pk_bf16(v[j].z, v[j].w);
                *(u32x2*)(H1 + (size_t)m * D + 4 * lane + 256 * j) = o;
#pragma unroll
                for (int e = 0; e < 4; ++e) { const int k = 4 * lane + 256 * j + e; const f32x4 wa = *(const LAS f32x4*)(wgt + k * 8), wb = *(const LAS f32x4*)(wgt + k * 8 + 4); const float hv = v[j][e];
                    d0 += hv * wa.x; d1 += hv * wa.y; d2 += hv * wa.z; d3 += hv * wa.w; d4 += hv * wb.x; d5 += hv * wb.y; d6 += hv * wb.z; d7 += hv * wb.w; }
            }
            d0 = wave_sum(d0); d1 = wave_sum(d1); d2 = wave_sum(d2); d3 = wave_sum(d3); d4 = wave_sum(d4); d5 = wave_sum(d5); d6 = wave_sum(d6); d7 = wave_sum(d7);
            if (lane < 8) {
                float dv = lane == 0 ? d0 : lane == 1 ? d1 : lane == 2 ? d2 : lane == 3 ? d3 : lane == 4 ? d4 : lane == 5 ? d5 : lane == 6 ? d6 : d7;
                float o;
                if (lane < 4) o = dv + bgi[lane]; else o = logsigmoid_(dv + bgf[lane - 4]);
                GATES[(size_t)m * 8 + lane] = o;
            }
        }
    }
    {
        bf16* PB = (bf16*)(ws + WS_PB);
        const int total = MT * PLE / 8;
        for (int i = wg * 512 + tid; i < total; i += nwg * 512) {
            const size_t e = (size_t)i * 8;
            const float* src = (e < (size_t)MP * PLE) ? P.in[6] + e : P.in[7] + (e - (size_t)MP * PLE);
            const f32x4 a = *(const f32x4*)src, b = *(const f32x4*)(src + 4);
            u32x4 o; o.x = cvt_pk_bf16(a.x, a.y); o.y = cvt_pk_bf16(a.z, a.w); o.z = cvt_pk_bf16(b.x, b.y); o.w = cvt_pk_bf16(b.z, b.w);
            *(u32x4*)(PB + e) = o;
        }
    }
    {
        constexpr int I1 = 16 * 64, I2 = 16 * 48, I3 = 16 * 32, I4 = 16 * 128, I5 = 64 * 32, I6 = 16 * 32, I7 = 4 * 32;
        constexpr int NIT = I1 + I2 + I3 + I4 + I5 + I6 + I7;
        for (int it = gw; it < NIT; it += NGW) {
            int r = it;
            if (r < I1) { p0_transpose_item(P.in[9], 1024, NIN, 0, 2048, (bf16*)(ws + WS_W1T), 0, nullptr, 0.08838834764831845f, scr, r, lane); continue; } r -= I1;
            if (r < I2) { p0_transpose_item(P.in[9], 1024, NIN, 2056, 1536, (bf16*)(ws + WS_W1T), 2048, nullptr, 1.0f, scr, r, lane); continue; } r -= I2;
            if (r < I3) { p0_transpose_item(P.in[14], 1024, 1024, 0, 1024, (bf16*)(ws + WS_WOT), 0, nullptr, 1.0f, scr, r, lane); continue; } r -= I3;
            if (r < I4) { p0_transpose_item(P.in[16], 1024, 4096, 0, 4096, (bf16*)(ws + WS_WUPT), 0, P.in[15], 1.0f, scr, r, lane); continue; } r -= I4;
            if (r < I5) { p0_transpose_item(P.in[17], 4096, 1024, 0, 1024, (bf16*)(ws + WS_WDNT), 0, nullptr, 1.0f, scr, r, lane); continue; } r -= I5;
            if (r < I6) { p0_transpose_item(P.in[19], 1024, 1024, 0, 1024, (bf16*)(ws + WS_WGT), 0, P.in[18], 1.0f, scr, r, lane); continue; } r -= I6;
            p0_transpose_item(P.in[20], 256, 1024, 0, 1024, (bf16*)(ws + WS_WPT), 0, nullptr, 1.0f, scr, r, lane);
        }
    }
}

template <int KS, class F>
__device__ __forceinline__ void small_gemm(const bf16* A, const bf16* Bt, int N, int K, LAS float* red, int wg, int nwg, const F& epi) {
    const int tid = threadIdx.x, lane = tid & 63, wave = tid >> 6, fr = lane & 15, fq = lane >> 4;
    constexpr int TPW = 8 / KS;
    const int sub = wave / KS, kp = wave % KS;
    const int ntiles = 8 * (N / 16), nit = (ntiles + nwg * TPW - 1) / (nwg * TPW);
    const int klen = K / KS, steps = klen / 32;
    for (int it = 0; it < nit; ++it) {
        const int T = (it * nwg + wg) * TPW + sub; const bool valid = T < ntiles;
        const int ct = T >> 3, rt = T & 7;
        f32x4 acc = {0.f, 0.f, 0.f, 0.f};
        if (valid) {
            const bf16* ap = A + (size_t)(rt * 16 + fr) * K + kp * klen + fq * 8;
            const bf16* bp = Bt + (size_t)(ct * 16 + fr) * K + kp * klen + fq * 8;
#pragma unroll 8
            for (int s = 0; s < steps; ++s) { const bf16x8 a = *(const bf16x8*)(ap + s * 32), b = *(const bf16x8*)(bp + s * 32); acc = __builtin_amdgcn_mfma_f32_16x16x32_bf16(b, a, acc, 0, 0, 0); }
        }
        if (KS > 1) {
            *(LAS f32x4*)(red + wave * 256 + lane * 4) = acc;
            __syncthreads();
            if (kp == 0) {
#pragma unroll
                for (int j = 1; j < KS; ++j) acc += *(const LAS f32x4*)(red + (wave + j) * 256 + lane * 4);
            }
        }
        if (valid && kp == 0) epi(rt * 16 + fr, ct * 16 + fq * 4, acc);
        if (KS > 1) __syncthreads();
    }
}

struct EpiStoreBf16 {
    static constexpr bool PERM = true, AFTER_DRAIN = false;
    bf16* O; int ldc;
    __device__ __forceinline__ void operator()(const f32x4 (&acc)[2][2][4][2], const pg8::Unit& u, int wr, int wc, int fr, int fq) const {
        const int row0 = u.pm * 256 + wr * 64 + fr, col0 = u.pn * 256 + wc * 32 + 8 * fq;
#pragma unroll
        for (int ai = 0; ai < 2; ++ai)
#pragma unroll
            for (int m = 0; m < 4; ++m) { bf16* rowp = O + (size_t)(row0 + ai * 128 + m * 16) * ldc + col0;
#pragma unroll
                for (int bj = 0; bj < 2; ++bj) { const f32x4 v0 = acc[ai][bj][m][0], v1 = acc[ai][bj][m][1];
                    u32x4 w; w.x = cvt_pk_bf16(v0[0], v0[1]); w.y = cvt_pk_bf16(v0[2], v0[3]); w.z = cvt_pk_bf16(v1[0], v1[1]); w.w = cvt_pk_bf16(v1[2], v1[3]);
                    *(u32x4*)(rowp + bj * 128) = w; }
                asm volatile("" ::: "memory"); }
    }
};
struct EpiRes {
    static constexpr bool PERM = true, AFTER_DRAIN = false;
    const float* base; float* XO; bf16* XB; float* SSP;
    __device__ __forceinline__ void operator()(const f32x4 (&acc)[2][2][4][2], const pg8::Unit& u, int wr, int wc, int fr, int fq) const {
        const int row0 = u.pm * 256 + wr * 64 + fr, col0 = u.pn * 256 + wc * 32 + 8 * fq;
#pragma unroll
        for (int ai = 0; ai < 2; ++ai)
#pragma unroll
            for (int m = 0; m < 4; ++m) { const int row = row0 + ai * 128 + m * 16; const size_t off = (size_t)row * D + col0; float ss = 0.f;
#pragma unroll
                for (int bj = 0; bj < 2; ++bj) {
                    const f32x4 b0 = *(const f32x4*)(base + off + bj * 128), b1 = *(const f32x4*)(base + off + bj * 128 + 4);
                    const f32x4 v0 = acc[ai][bj][m][0] + b0, v1 = acc[ai][bj][m][1] + b1;
                    *(f32x4*)(XO + off + bj * 128) = v0; *(f32x4*)(XO + off + bj * 128 + 4) = v1;
                    u32x4 w; w.x = cvt_pk_bf16(v0[0], v0[1]); w.y = cvt_pk_bf16(v0[2], v0[3]); w.z = cvt_pk_bf16(v1[0], v1[1]); w.w = cvt_pk_bf16(v1[2], v1[3]);
                    *(u32x4*)(XB + off + bj * 128) = w;
                    ss += (v0[0] * v0[0] + v0[1] * v0[1]) + (v0[2] * v0[2] + v0[3] * v0[3]) + (v1[0] * v1[0] + v1[1] * v1[1]) + (v1[2] * v1[2] + v1[3] * v1[3]); }
                ss += __shfl_xor(ss, 16); ss += __shfl_xor(ss, 32);
                if (fq == 0) SSP[(size_t)row * 16 + u.pn * 4 + wc] = ss;
                asm volatile("" ::: "memory"); }
    }
};
__device__ __forceinline__ float row_rs16(const float* SSP, int row) {
    const f32x4 a = *(const f32x4*)(SSP + (size_t)row * 16), b = *(const f32x4*)(SSP + (size_t)row * 16 + 4), c = *(const f32x4*)(SSP + (size_t)row * 16 + 8), d = *(const f32x4*)(SSP + (size_t)row * 16 + 12);
    const float s = ((a.x + a.y) + (a.z + a.w)) + ((b.x + b.y) + (b.z + b.w)) + ((c.x + c.y) + (c.z + c.w)) + ((d.x + d.y) + (d.z + d.w));
    return rsqrtf(s * (1.f / D) + EPS);
}
__device__ __forceinline__ float row_rs64(const float* SSS, int row) {
    float s = 0.f;
#pragma unroll
    for (int j = 0; j < 16; ++j) { const f32x4 a = *(const f32x4*)(SSS + (size_t)row * 64 + 4 * j); s += (a.x + a.y) + (a.z + a.w); }
    return rsqrtf(s * (1.f / D) + EPS);
}
struct EpiUp {
    static constexpr bool PERM = true, AFTER_DRAIN = false;
    bf16* O; const float* SSP;
    __device__ __forceinline__ void operator()(const f32x4 (&acc)[2][2][4][2], const pg8::Unit& u, int wr, int wc, int fr, int fq) const {
        const int row0 = u.pm * 256 + wr * 64 + fr, col0 = u.pn * 256 + wc * 32 + 8 * fq;
#pragma unroll
        for (int ai = 0; ai < 2; ++ai)
#pragma unroll
            for (int m = 0; m < 4; ++m) { const int row = row0 + ai * 128 + m * 16; const float r = row_rs16(SSP, row); bf16* rowp = O + (size_t)row * FF + col0;
#pragma unroll
                for (int bj = 0; bj < 2; ++bj) { f32x4 v0 = acc[ai][bj][m][0] * r, v1 = acc[ai][bj][m][1] * r;
#pragma unroll
                    for (int e = 0; e < 4; ++e) { const float a = fmaxf(v0[e], 0.f), b = fmaxf(v1[e], 0.f); v0[e] = a * a; v1[e] = b * b; }
                    u32x4 w; w.x = cvt_pk_bf16(v0[0], v0[1]); w.y = cvt_pk_bf16(v0[2], v0[3]); w.z = cvt_pk_bf16(v1[0], v1[1]); w.w = cvt_pk_bf16(v1[2], v1[3]);
                    *(u32x4*)(rowp + bj * 128) = w; }
                asm volatile("" ::: "memory"); }
    }
};
struct EpiPle {
    static constexpr bool PERM = true, AFTER_DRAIN = false;
    float* X; const bf16* PP; const float* SSP;
    __device__ __forceinline__ void operator()(const f32x4 (&acc)[2][2][4][2], const pg8::Unit& u, int wr, int wc, int fr, int fq) const {
        const int row0 = u.pm * 256 + wr * 64 + fr, col0 = u.pn * 256 + wc * 32 + 8 * fq;
#pragma unroll
        for (int ai = 0; ai < 2; ++ai)
#pragma unroll
            for (int m = 0; m < 4; ++m) { const int row = row0 + ai * 128 + m * 16; const float r = row_rs16(SSP, row); const size_t off = (size_t)row * D + col0;
#pragma unroll
                for (int bj = 0; bj < 2; ++bj) {
                    const f32x4 b0 = *(const f32x4*)(X + off + bj * 128), b1 = *(const f32x4*)(X + off + bj * 128 + 4);
                    const u32x4 pw = *(const u32x4*)(PP + off + bj * 128);
                    const f32x4 a0 = acc[ai][bj][m][0] * r, a1 = acc[ai][bj][m][1] * r;
                    f32x4 v0, v1;
                    v0[0] = b0[0] + sigmoidf_(a0[0]) * bflo(pw.x); v0[1] = b0[1] + sigmoidf_(a0[1]) * bfhi(pw.x); v0[2] = b0[2] + sigmoidf_(a0[2]) * bflo(pw.y); v0[3] = b0[3] + sigmoidf_(a0[3]) * bfhi(pw.y);
                    v1[0] = b1[0] + sigmoidf_(a1[0]) * bflo(pw.z); v1[1] = b1[1] + sigmoidf_(a1[1]) * bfhi(pw.z); v1[2] = b1[2] + sigmoidf_(a1[2]) * bflo(pw.w); v1[3] = b1[3] + sigmoidf_(a1[3]) * bfhi(pw.w);
                    *(f32x4*)(X + off + bj * 128) = v0; *(f32x4*)(X + off + bj * 128 + 4) = v1; }
                asm volatile("" ::: "memory"); }
    }
};
struct UpperHalfOrder {
    int G, c, nM, nN;
    __device__ bool next(int i, pg8::Unit& u) const { const int h = G / 2; if (c < h) return false; const int L = (c - h) + i * (G - h); if (L >= nM * nN) return false; u.pm = L / nN; u.pn = L % nN; return true; }
    __device__ __forceinline__ void a_ready(const pg8::Unit&) const {}
    __device__ __forceinline__ void done(const pg8::Unit&) const {}
};

__device__ __forceinline__ float scan_add(float v, int lane) {
#pragma unroll
    for (int o = 1; o < 64; o <<= 1) { const float t = __shfl_up(v, o); if (lane >= o) v += t; }
    return v;
}
__device__ __forceinline__ float scan_max(float v, int lane) {
#pragma unroll
    for (int o = 1; o < 64; o <<= 1) { const float t = __shfl_up(v, o); if (lane >= o) v = fmaxf(v, t); }
    return v;
}
constexpr int TS = 72;

__device__ __forceinline__ void phase2a(const Params& P, LAS unsigned char* lds, int wg, int nwg) {
    const int tid = threadIdx.x, lane = tid & 63, wave = tid >> 6, fr = lane & 15, fq = lane >> 4;
    unsigned char* ws = P.ws;
    const bf16* Z = (const bf16*)(ws + WS_Z); const float* GATES = (const float*)(ws + WS_GATES);
    bf16* MIX = (bf16*)(ws + WS_MIX);
    float* BL = (float*)(ws + WS_SMALL); float* AMAX = BL + 1024;
    float* U = P.out;
    float* UN = (float*)(ws + WS_UN);
    LAS bf16* Kt = (LAS bf16*)lds; LAS bf16* Vt = Kt + 128 * TS; LAS float* sw = (LAS float*)(lds + 2 * 128 * TS * 2);
    for (int item = wg; item < NITEM; item += nwg) {
        const int b = item >> 7, h = (item >> 5) & 3, c = item & 31, r0 = b * SEQ + c * CH;
        if (wave == 0) {
            const float lf = GATES[(size_t)(r0 + lane) * 8 + 4 + h], ig = GATES[(size_t)(r0 + lane) * 8 + h];
            const float bc = scan_add(lf, lane), a = ig - bc, am = wave_max(a);
            sw[lane] = __expf(a - am);
            if (lane == 63) BL[item] = bc;
            if (lane == 0) AMAX[item] = am;
        }
        __syncthreads();
        {
            const int s = tid >> 3, seg = tid & 7;
            const bf16* zr = Z + (size_t)(r0 + s) * NZ + h * HD + seg * 16;
            const u32x4 k0 = *(const u32x4*)(zr + 512), k1 = *(const u32x4*)(zr + 512 + 8), v0 = *(const u32x4*)(zr + 1024), v1 = *(const u32x4*)(zr + 1024 + 8);
            const float w = sw[s];
            const unsigned kk[8] = {k0.x, k0.y, k0.z, k0.w, k1.x, k1.y, k1.z, k1.w}, vv[8] = {v0.x, v0.y, v0.z, v0.w, v1.x, v1.y, v1.z, v1.w};
#pragma unroll
            for (int e = 0; e < 8; ++e) {
                const int d = seg * 16 + 2 * e;
                Kt[d * TS + s] = (bf16)f2bf(w * bflo(kk[e])); Kt[(d + 1) * TS + s] = (bf16)f2bf(w * bfhi(kk[e]));
                Vt[d * TS + s] = (bf16)(vv[e] & 0xffffu); Vt[(d + 1) * TS + s] = (bf16)(vv[e] >> 16);
            }
        }
        __syncthreads();
        {
            const bf16x8 vf0 = *(const LAS bf16x8*)(Vt + (wave * 16 + fr) * TS + fq * 8), vf1 = *(const LAS bf16x8*)(Vt + (wave * 16 + fr) * TS + 32 + fq * 8);
            float* up = U + (size_t)item * 16384 + (size_t)(wave * 16 + fr) * 128 + fq * 4;
#pragma unroll
            for (int dkt = 0; dkt < 8; ++dkt) {
                const bf16x8 kf0 = *(const LAS bf16x8*)(Kt + (dkt * 16 + fr) * TS + fq * 8), kf1 = *(const LAS bf16x8*)(Kt + (dkt * 16 + fr) * TS + 32 + fq * 8);
                f32x4 acc = {0.f, 0.f, 0.f, 0.f};
                acc = __builtin_amdgcn_mfma_f32_16x16x32_bf16(kf0, vf0, acc, 0, 0, 0);
                acc = __builtin_amdgcn_mfma_f32_16x16x32_bf16(kf1, vf1, acc, 0, 0, 0);
                *(f32x4*)(up + dkt * 16) = acc;
            }
            if (tid < 128) { float s = 0.f;
#pragma unroll 8
                for (int j = 0; j < 64; ++j) s += bf2f(Kt[tid * TS + j]);
                UN[(size_t)item * 128 + tid] = s; }
        }
        __syncthreads();
    }
    {
        const float* cw = P.in[13];
        const int c0 = lane * 8;
        float w0[8], w1[8], w2[8];
#pragma unroll
        for (int e = 0; e < 8; ++e) { w0[e] = cw[c0 + e]; w1[e] = cw[512 + c0 + e]; w2[e] = cw[1024 + c0 + e]; }
        const int gw = wg * 8 + wave, NGW = nwg * 8;
        for (int st = gw; st < MP / 8; st += NGW) {
            const int r0 = st * 8, t0 = r0 & (SEQ - 1);
            float cm2[8], cm1[8];
#pragma unroll
            for (int e = 0; e < 8; ++e) { cm2[e] = 0.f; cm1[e] = 0.f; }
            if (t0 != 0) {
                const u32x4 ga = *(const u32x4*)(Z + (size_t)(r0 - 2) * NZ + 2560 + c0), ua = *(const u32x4*)(Z + (size_t)(r0 - 2) * NZ + 3072 + c0);
                const u32x4 gb2 = *(const u32x4*)(Z + (size_t)(r0 - 1) * NZ + 2560 + c0), ub = *(const u32x4*)(Z + (size_t)(r0 - 1) * NZ + 3072 + c0);
                const unsigned g1[4] = {ga.x, ga.y, ga.z, ga.w}, u1[4] = {ua.x, ua.y, ua.z, ua.w}, g2[4] = {gb2.x, gb2.y, gb2.z, gb2.w}, u2[4] = {ub.x, ub.y, ub.z, ub.w};
#pragma unroll
                for (int e = 0; e < 4; ++e) { cm2[2 * e] = bflo(g1[e]) * bflo(u1[e]); cm2[2 * e + 1] = bfhi(g1[e]) * bfhi(u1[e]); cm1[2 * e] = bflo(g2[e]) * bflo(u2[e]); cm1[2 * e + 1] = bfhi(g2[e]) * bfhi(u2[e]); }
            }
#pragma unroll
            for (int rr = 0; rr < 8; ++rr) {
                const bf16* zr = Z + (size_t)(r0 + rr) * NZ;
                const u32x4 gbv = *(const u32x4*)(zr + 2048 + c0), gcv = *(const u32x4*)(zr + 2560 + c0), uv = *(const u32x4*)(zr + 3072 + c0);
                const unsigned gb_[4] = {gbv.x, gbv.y, gbv.z, gbv.w}, gc_[4] = {gcv.x, gcv.y, gcv.z, gcv.w}, u_[4] = {uv.x, uv.y, uv.z, uv.w};
                float y[8];
#pragma unroll
                for (int e = 0; e < 4; ++e) {
                    const float cu0 = bflo(gc_[e]) * bflo(u_[e]), cu1 = bfhi(gc_[e]) * bfhi(u_[e]);
                    y[2 * e] = bflo(gb_[e]) * (w0[2 * e] * cm2[2 * e] + w1[2 * e] * cm1[2 * e] + w2[2 * e] * cu0);
                    y[2 * e + 1] = bfhi(gb_[e]) * (w0[2 * e + 1] * cm2[2 * e + 1] + w1[2 * e + 1] * cm1[2 * e + 1] + w2[2 * e + 1] * cu1);
                    cm2[2 * e] = cm1[2 * e]; cm2[2 * e + 1] = cm1[2 * e + 1]; cm1[2 * e] = cu0; cm1[2 * e + 1] = cu1;
                }
                u32x4 o; o.x = cvt_pk_bf16(y[0], y[1]); o.y = cvt_pk_bf16(y[2], y[3]); o.z = cvt_pk_bf16(y[4], y[5]); o.w = cvt_pk_bf16(y[6], y[7]);
                *(u32x4*)(MIX + (size_t)(r0 + rr) * D + 512 + c0) = o;
            }
            if (t0 + 8 == SEQ) {
                float* pc = P.out + OUT_PCONV + (size_t)(r0 / SEQ) * 1024 + c0;
                *(f32x4*)pc = (f32x4){cm2[0], cm2[1], cm2[2], cm2[3]}; *(f32x4*)(pc + 4) = (f32x4){cm2[4], cm2[5], cm2[6], cm2[7]};
                *(f32x4*)(pc + 512) = (f32x4){cm1[0], cm1[1], cm1[2], cm1[3]}; *(f32x4*)(pc + 516) = (f32x4){cm1[4], cm1[5], cm1[6], cm1[7]};
            }
        }
        const float* sconv = P.in[5];
        for (int i = gw; i < MS; i += NGW) {
            const bf16* zr = Z + (size_t)(MP + i) * NZ;
            const u32x4 gbv = *(const u32x4*)(zr + 2048 + c0), gcv = *(const u32x4*)(zr + 2560 + c0), uv = *(const u32x4*)(zr + 3072 + c0);
            const unsigned gb_[4] = {gbv.x, gbv.y, gbv.z, gbv.w}, gc_[4] = {gcv.x, gcv.y, gcv.z, gcv.w}, u_[4] = {uv.x, uv.y, uv.z, uv.w};
            const float* s0p = sconv + (size_t)i * 1024 + c0;
            const f32x4 s0a = *(const f32x4*)s0p, s0b = *(const f32x4*)(s0p + 4), s1a = *(const f32x4*)(s0p + 512), s1b = *(const f32x4*)(s0p + 516);
            const float s0[8] = {s0a.x, s0a.y, s0a.z, s0a.w, s0b.x, s0b.y, s0b.z, s0b.w}, s1[8] = {s1a.x, s1a.y, s1a.z, s1a.w, s1b.x, s1b.y, s1b.z, s1b.w};
            float y[8], cu[8];
#pragma unroll
            for (int e = 0; e < 4; ++e) {
                cu[2 * e] = bflo(gc_[e]) * bflo(u_[e]); cu[2 * e + 1] = bfhi(gc_[e]) * bfhi(u_[e]);
                y[2 * e] = bflo(gb_[e]) * (w0[2 * e] * s0[2 * e] + w1[2 * e] * s1[2 * e] + w2[2 * e] * cu[2 * e]);
                y[2 * e + 1] = bfhi(gb_[e]) * (w0[2 * e + 1] * s0[2 * e + 1] + w1[2 * e + 1] * s1[2 * e + 1] + w2[2 * e + 1] * cu[2 * e + 1]);
            }
            u32x4 o; o.x = cvt_pk_bf16(y[0], y[1]); o.y = cvt_pk_bf16(y[2], y[3]); o.z = cvt_pk_bf16(y[4], y[5]); o.w = cvt_pk_bf16(y[6], y[7]);
            *(u32x4*)(MIX + (size_t)(MP + i) * D + 512 + c0) = o;
            float* sc = P.out + OUT_SCONV + (size_t)i * 1024 + c0;
            *(f32x4*)sc = s1a; *(f32x4*)(sc + 4) = s1b;
            *(f32x4*)(sc + 512) = (f32x4){cu[0], cu[1], cu[2], cu[3]}; *(f32x4*)(sc + 516) = (f32x4){cu[4], cu[5], cu[6], cu[7]};
        }
    }
    {
        LAS float* sq = (LAS float*)lds; LAS float* sk = sq + 128; LAS float* sv = sk + 128; LAS float* sn = sv + 128; LAS float* red = sn + 128;
        const float* C0 = P.in[2]; const float* N0 = P.in[3]; const float* M0 = P.in[4];
        const float* mhn = P.in[12];
        for (int item = wg; item < MS * NH; item += nwg) {
            const int i = item >> 2, h = item & 3, row = MP + i;
            const bf16* zr = Z + (size_t)row * NZ + h * HD;
            if (tid < 128) { sq[tid] = bf2f(zr[tid]); sk[tid] = bf2f(zr[512 + tid]); sv[tid] = bf2f(zr[1024 + tid]); sn[tid] = N0[(size_t)item * 128 + tid]; }
            const float ig = GATES[(size_t)row * 8 + h], lf = GATES[(size_t)row * 8 + 4 + h], m0 = M0[item];
            const float mt = fmaxf(lf + m0, ig), dsc = __expf(ig - mt), decay = __expf(lf + m0 - mt);
            __syncthreads();
            const float qk = wave_sum(sq[lane] * sk[lane] + sq[lane + 64] * sk[lane + 64]);
            const float qn = wave_sum(sq[lane] * sn[lane] + sq[lane + 64] * sn[lane + 64]);
            const int c4 = tid & 31, kr = tid >> 5;
            const f32x4 v4 = *(const LAS f32x4*)(sv + c4 * 4);
            const float* cp = C0 + (size_t)item * 16384 + c4 * 4; float* co = P.out + OUT_SC + (size_t)item * 16384 + c4 * 4;
            f32x4 part = {0.f, 0.f, 0.f, 0.f};
#pragma unroll
            for (int j = 0; j < 8; ++j) { const int dk = kr + 16 * j; const f32x4 cv = *(const f32x4*)(cp + (size_t)dk * 128);
                part += cv * sq[dk]; *(f32x4*)(co + (size_t)dk * 128) = cv * decay + v4 * (dsc * sk[dk]); }
            *(LAS f32x4*)(red + kr * 128 + c4 * 4) = part;
            if (tid < 128) P.out[OUT_SN + (size_t)item * 128 + tid] = decay * sn[tid] + dsc * sk[tid];
            if (tid == 0) P.out[OUT_SM + item] = mt;
            __syncthreads();
            if (wave == 0) {
                float qc0 = 0.f, qc1 = 0.f;
#pragma unroll
                for (int j = 0; j < 16; ++j) { qc0 += red[j * 128 + lane]; qc1 += red[j * 128 + lane + 64]; }
                const float scores = qk * dsc, den = scores + decay * qn, dn = fmaxf(fabsf(den), __expf(-mt));
                const float h0 = (scores * sv[lane] + decay * qc0) / dn, h1 = (scores * sv[lane + 64] + decay * qc1) / dn;
                const float rn = rsqrtf(wave_sum(h0 * h0 + h1 * h1) * (1.f / HD) + EPS);
                const float o0 = h0 * rn * mhn[h * HD + lane] * sigmoidf_(bf2f(zr[1536 + lane])), o1 = h1 * rn * mhn[h * HD + lane + 64] * sigmoidf_(bf2f(zr[1536 + lane + 64]));
                MIX[(size_t)row * D + h * HD + lane] = (bf16)f2bf(o0); MIX[(size_t)row * D + h * HD + lane + 64] = (bf16)f2bf(o1);
            }
            __syncthreads();
        }
    }
}

__device__ __forceinline__ void phase2b(const Params& P, int wg, int nwg) {
    const int tid = threadIdx.x;
    unsigned char* ws = P.ws;
    const float* BL = (const float*)(ws + WS_SMALL); const float* AMAX = BL + 1024; float* MPREV = (float*)(ws + WS_SMALL) + 2048;
    const float* U = P.out; const float* UN = (const float*)(ws + WS_UN); float* NPREV = (float*)(ws + WS_NPREV);
    bf16* CP = (bf16*)(ws + WS_H1);
    for (int id = wg; id < 256; id += nwg) {
        const int bh = id >> 3, part = id & 7, e = part * 2048 + tid * 4;
        const bool don = (part == 0 && tid < 128);
        f32x4 C = {0.f, 0.f, 0.f, 0.f}; float n = 0.f, m = M_INIT;
#pragma unroll 4
        for (int c = 0; c < NCH; ++c) {
            const int it = bh * NCH + c;
            const float bl = BL[it], am = AMAX[it];
            const float mn = bl + fmaxf(m, am), al = __expf(bl + m - mn), be = __expf(bl + am - mn);
            u32x2 o; o.x = cvt_pk_bf16(C[0], C[1]); o.y = cvt_pk_bf16(C[2], C[3]);
            *(u32x2*)(CP + (size_t)it * 16384 + e) = o;
            const f32x4 u = *(const f32x4*)(U + (size_t)it * 16384 + e);
            C = C * al + u * be;
            if (don) { NPREV[(size_t)it * 128 + tid] = n; n = al * n + be * UN[(size_t)it * 128 + tid]; }
            if (part == 0 && tid == 0) MPREV[it] = m;
            m = mn;
        }
        const int dv = e >> 7, dk = e & 127;
        float* pc = P.out + OUT_PC + (size_t)bh * 16384 + dv;
#pragma unroll
        for (int j = 0; j < 4; ++j) pc[(size_t)(dk + j) * 128] = C[j];
        if (don) P.out[OUT_PN + bh * 128 + tid] = n;
        if (part == 0 && tid == 0) P.out[OUT_PM + bh] = m;
    }
}

__device__ __forceinline__ void phase2c(const Params& P, LAS unsigned char* lds, int wg, int nwg) {
    const int tid = threadIdx.x, lane = tid & 63, wave = tid >> 6, fr = lane & 15, fq = lane >> 4;
    unsigned char* ws = P.ws;
    const bf16* Z = (const bf16*)(ws + WS_Z); const float* GATES = (const float*)(ws + WS_GATES);
    bf16* MIX = (bf16*)(ws + WS_MIX);
    const float* MPREV = (const float*)(ws + WS_SMALL) + 2048; const float* NPREV = (const float*)(ws + WS_NPREV);
    const bf16* CP = (const bf16*)(ws + WS_H1);
    const float* mhn = P.in[12];
    LAS bf16* Vt = (LAS bf16*)lds;
    LAS bf16* Pm = Vt + 128 * TS;
    LAS float* sa = (LAS float*)(lds + (128 + 64) * TS * 2); LAS float* sg = sa + 64; LAS float* sdec = sg + 64; LAS float* seinv = sdec + 64;
    LAS float* denp = seinv + 64;
    LAS float* sqn = denp + 256;
    LAS float* sss = sqn + 64;
    for (int item = wg; item < NITEM; item += nwg) {
        const int b = item >> 7, h = (item >> 5) & 3, c = item & 31, r0 = b * SEQ + c * CH;
        if (wave == 0) {
            const float lf = GATES[(size_t)(r0 + lane) * 8 + 4 + h], ig = GATES[(size_t)(r0 + lane) * 8 + h];
            const float bc = scan_add(lf, lane), a = ig - bc, mx = scan_max(a, lane), mp = MPREV[item];
            const float g = fmaxf(mp, mx), mt = bc + g;
            sa[lane] = a; sg[lane] = g; sdec[lane] = __expf(mp - g); seinv[lane] = __expf(-mt);
        }
        {
            const int s = tid >> 3, seg = tid & 7;
            const bf16* zr = Z + (size_t)(r0 + s) * NZ + 1024 + h * HD + seg * 16;
            const u32x4 v0 = *(const u32x4*)zr, v1 = *(const u32x4*)(zr + 8);
            const unsigned vv[8] = {v0.x, v0.y, v0.z, v0.w, v1.x, v1.y, v1.z, v1.w};
#pragma unroll
            for (int e = 0; e < 8; ++e) { const int d = seg * 16 + 2 * e; Vt[d * TS + s] = (bf16)(vv[e] & 0xffffu); Vt[(d + 1) * TS + s] = (bf16)(vv[e] >> 16); }
        }
        const int tt = wave & 3, hh = wave >> 2, t = tt * 16 + fr;
        bf16x8 qf[4];
        {
            const bf16* qp = Z + (size_t)(r0 + t) * NZ + h * HD + fq * 8;
#pragma unroll
            for (int ks = 0; ks < 4; ++ks) qf[ks] = *(const bf16x8*)(qp + ks * 32);
        }
        __syncthreads();
#pragma unroll
        for (int si = 0; si < 2; ++si) {
            const int st = hh * 2 + si;
            f32x4 acc = {0.f, 0.f, 0.f, 0.f};
            if (st <= tt) {
                const bf16* kp = Z + (size_t)(r0 + st * 16 + fr) * NZ + 512 + h * HD + fq * 8;
#pragma unroll
                for (int ks = 0; ks < 4; ++ks) { const bf16x8 kf = *(const bf16x8*)(kp + ks * 32); acc = __builtin_amdgcn_mfma_f32_16x16x32_bf16(kf, qf[ks], acc, 0, 0, 0); }
            }
            const float gt = sg[t];
            float p[4]; float ps = 0.f;
#pragma unroll
            for (int r = 0; r < 4; ++r) { const int s = st * 16 + fq * 4 + r; const float e = __expf(sa[s] - gt); p[r] = (s <= t) ? acc[r] * e : 0.f; ps += p[r]; }
            u32x2 o; o.x = cvt_pk_bf16(p[0], p[1]); o.y = cvt_pk_bf16(p[2], p[3]);
            *(LAS u32x2*)(Pm + t * TS + st * 16 + fq * 4) = o;
            ps += __shfl_xor(ps, 16); ps += __shfl_xor(ps, 32);
            if (fq == 0) denp[st * 64 + t] = ps;
        }
        if (hh == 0) {
            const float* np = NPREV + (size_t)item * 128 + fq * 8; float s = 0.f;
#pragma unroll
            for (int ks = 0; ks < 4; ++ks) { const f32x4 n0 = *(const f32x4*)(np + ks * 32), n1 = *(const f32x4*)(np + ks * 32 + 4);
                const bf16x8 q = qf[ks];
                s += bf2f((unsigned short)q[0]) * n0.x + bf2f((unsigned short)q[1]) * n0.y + bf2f((unsigned short)q[2]) * n0.z + bf2f((unsigned short)q[3]) * n0.w
                   + bf2f((unsigned short)q[4]) * n1.x + bf2f((unsigned short)q[5]) * n1.y + bf2f((unsigned short)q[6]) * n1.z + bf2f((unsigned short)q[7]) * n1.w; }
            s += __shfl_xor(s, 16); s += __shfl_xor(s, 32);
            if (fq == 0) sqn[t] = s;
        }
        __syncthreads();
        f32x4 a1[4], a2[4];
#pragma unroll
        for (int d = 0; d < 4; ++d) { a1[d] = (f32x4){0.f, 0.f, 0.f, 0.f}; a2[d] = (f32x4){0.f, 0.f, 0.f, 0.f}; }
        {
            const bf16x8 pf0 = *(const LAS bf16x8*)(Pm + t * TS + fq * 8), pf1 = *(const LAS bf16x8*)(Pm + t * TS + 32 + fq * 8);
#pragma unroll
            for (int d = 0; d < 4; ++d) { const int dvr = (hh * 4 + d) * 16 + fr;
                const bf16x8 vf0 = *(const LAS bf16x8*)(Vt + dvr * TS + fq * 8), vf1 = *(const LAS bf16x8*)(Vt + dvr * TS + 32 + fq * 8);
                a1[d] = __builtin_amdgcn_mfma_f32_16x16x32_bf16(vf0, pf0, a1[d], 0, 0, 0);
                a1[d] = __builtin_amdgcn_mfma_f32_16x16x32_bf16(vf1, pf1, a1[d], 0, 0, 0);
                const bf16* cp = CP + (size_t)item * 16384 + (size_t)dvr * 128 + fq * 8;
#pragma unroll
                for (int ks = 0; ks < 4; ++ks) { const bf16x8 cf = *(const bf16x8*)(cp + ks * 32); a2[d] = __builtin_amdgcn_mfma_f32_16x16x32_bf16(cf, qf[ks], a2[d], 0, 0, 0); }
            }
        }
        const float dec = sdec[t];
        const float den = ((denp[t] + denp[64 + t]) + (denp[128 + t] + denp[192 + t])) + dec * sqn[t];
        const float inv = 1.0f / fmaxf(fabsf(den), seinv[t]);
        float ssq = 0.f;
#pragma unroll
        for (int d = 0; d < 4; ++d)
#pragma unroll
            for (int r = 0; r < 4; ++r) { const float hv = (a1[d][r] + dec * a2[d][r]) * inv; a1[d][r] = hv; ssq += hv * hv; }
        ssq += __shfl_xor(ssq, 16); ssq += __shfl_xor(ssq, 32);
        if (fq == 0) sss[hh * 64 + t] = ssq;
        __syncthreads();
        const float rn = rsqrtf((sss[t] + sss[64 + t]) * (1.f / HD) + EPS);
        const size_t row = (size_t)(r0 + t);
#pragma unroll
        for (int d = 0; d < 4; ++d) {
            const int col = h * HD + (hh * 4 + d) * 16 + fq * 4;
            const f32x4 mw = *(const f32x4*)(mhn + col);
            const u32x2 ogw = *(const u32x2*)(Z + row * NZ + 1536 + col);
            const float o0 = a1[d][0] * rn * mw.x * sigmoidf_(bflo(ogw.x)), o1 = a1[d][1] * rn * mw.y * sigmoidf_(bfhi(ogw.x));
            const float o2 = a1[d][2] * rn * mw.z * sigmoidf_(bflo(ogw.y)), o3 = a1[d][3] * rn * mw.w * sigmoidf_(bfhi(ogw.y));
            u32x2 o; o.x = cvt_pk_bf16(o0, o1); o.y = cvt_pk_bf16(o2, o3);
            *(u32x2*)(MIX + row * D + col) = o;
        }
        __syncthreads();
    }
}

__device__ __forceinline__ void phase7(const Params& P, int wg, int nwg) {
    const int tid = threadIdx.x, lane = tid & 63, wave = tid >> 6;
    const float* g = P.in[21];
    f32x4 gv[4];
#pragma unroll
    for (int j = 0; j < 4; ++j) gv[j] = *(const f32x4*)(g + 4 * lane + 256 * j);
    for (int m = wg * 8 + wave; m < MT; m += nwg * 8) {
        float* xr = P.out + (size_t)m * D + 4 * lane;
        f32x4 v[4]; float s = 0.f;
#pragma unroll
        for (int j = 0; j < 4; ++j) { v[j] = *(const f32x4*)(xr + 256 * j); s += (v[j].x * v[j].x + v[j].y * v[j].y) + (v[j].z * v[j].z + v[j].w * v[j].w); }
        const float r = rsqrtf(wave_sum(s) * (1.f / D) + EPS);
#pragma unroll
        for (int j = 0; j < 4; ++j) *(f32x4*)(xr + 256 * j) = v[j] * r * gv[j];
    }
}

__global__ void __launch_bounds__(512, 2) mk_fwd(Params P) {
    extern __shared__ __attribute__((aligned(16))) unsigned char lds_raw[];
    LAS unsigned char* lds = (LAS unsigned char*)lds_raw;
    const int wg = blockIdx.x, nwg = gridDim.x;
    unsigned char* ws = P.ws;
    const int lo = P.ph_lo, hi = P.ph_hi;
#ifndef PHMASK
#define PHMASK 0x3ff
#endif
#define IN(k) (((PHMASK >> (k)) & 1) && lo <= (k) && (k) < hi)
    volatile LAS unsigned* bst = (volatile LAS unsigned*)(lds + LDS_RED + 8192);
    if (threadIdx.x < 2) bst[threadIdx.x] = 0u;
    __syncthreads();
    XcdBarrier bar = xcd_barrier_post((unsigned*)(ws + WS_BAR), bst);
#define SEAM(k) do { if (IN(k) && IN((k) + 1)) xcd_barrier(bar); } while (0)
    LAS float* red = (LAS float*)(lds + LDS_RED);
    bf16* H1 = (bf16*)(ws + WS_H1); bf16* Zb = (bf16*)(ws + WS_Z); bf16* PP = (bf16*)(ws + WS_PP); bf16* PB = (bf16*)(ws + WS_PB);
    bf16* MIX = (bf16*)(ws + WS_MIX); bf16* HF = (bf16*)(ws + WS_HF);
    float* SSP1 = (float*)(ws + WS_SSP1); float* SSP2 = (float*)(ws + WS_SSP2);
    float* SSS1 = (float*)(ws + WS_SMALL) + 4096; float* SSS2 = SSS1 + 128 * 64;
    float* XR = P.out;

#ifndef DUPMASK
#define DUPMASK 0
#endif
#ifndef SYNCDUP
#define SYNCDUP 0
#endif
#define REPS(k) (1 + ((DUPMASK >> (k)) & 1))
#define SEAMS(k) do { SEAM(k); if (SYNCDUP) SEAM(k); } while (0)
    for (int rep = 0; rep < REPS(0); ++rep) if (IN(0)) { if (rep) __syncthreads(); phase0(P, lds, wg, nwg); }
    SEAMS(0);
    for (int rep = 0; rep < REPS(1); ++rep) if (IN(1)) {
        small_gemm<1>(H1 + (size_t)MP * D, (const bf16*)(ws + WS_W1T), NZ, D, red, wg, nwg,
            [&](int row, int col, const f32x4& v) { u32x2 o; o.x = cvt_pk_bf16(v[0], v[1]); o.y = cvt_pk_bf16(v[2], v[3]); *(u32x2*)(Zb + (size_t)(MP + row) * NZ + col) = o; });
        small_gemm<1>(PB + (size_t)MP * PLE, (const bf16*)(ws + WS_WPT), D, PLE, red, wg, nwg,
            [&](int row, int col, const f32x4& v) { u32x2 o; o.x = cvt_pk_bf16(v[0], v[1]); o.y = cvt_pk_bf16(v[2], v[3]); *(u32x2*)(PP + (size_t)(MP + row) * D + col) = o; });
        { pg8::Gemm g{H1, (const bf16*)(ws + WS_W1T), MP, NZ, D}; pg8::StaticOrder S; S.init(MP, NZ, nwg, wg); EpiStoreBf16 E{Zb, NZ};
          pg8::gemm_phase<EpiStoreBf16, pg8::StaticOrder, true, true>(lds, g, S, E); }
        { pg8::Gemm g{PB, (const bf16*)(ws + WS_WPT), MP, D, PLE}; UpperHalfOrder S{nwg, wg, MP / 256, D / 256}; EpiStoreBf16 E{PP, D};
          pg8::gemm_phase<EpiStoreBf16, UpperHalfOrder, false, true>(lds, g, S, E); }
    }
    SEAMS(1);
    for (int rep = 0; rep < REPS(2); ++rep) if (IN(2)) { phase2a(P, lds, wg, nwg); }
    SEAMS(2);
    for (int rep = 0; rep < REPS(3); ++rep) if (IN(3)) { phase2b(P, wg, nwg); }
    SEAMS(3);
    for (int rep = 0; rep < REPS(4); ++rep) if (IN(4)) { phase2c(P, lds, wg, nwg); }
    SEAMS(4);
    for (int rep = 0; rep < REPS(5); ++rep) if (IN(5)) {
        const float* xs = P.in[1];
        small_gemm<4>(MIX + (size_t)MP * D, (const bf16*)(ws + WS_WOT), D, D, red, wg, nwg,
            [&](int row, int col, const f32x4& v) { const size_t off = (size_t)(MP + row) * D + col; const f32x4 x = *(const f32x4*)(xs + (size_t)row * D + col) + v;
                *(f32x4*)(XR + off) = x; u32x2 o; o.x = cvt_pk_bf16(x[0], x[1]); o.y = cvt_pk_bf16(x[2], x[3]); *(u32x2*)(H1 + off) = o;
                float ss = (x[0] * x[0] + x[1] * x[1]) + (x[2] * x[2] + x[3] * x[3]); ss += __shfl_xor(ss, 16); ss += __shfl_xor(ss, 32);
                if ((threadIdx.x & 63) < 16) SSS1[row * 64 + (col >> 4)] = ss; });
        pg8::Gemm g{MIX, (const bf16*)(ws + WS_WOT), MP, D, D}; pg8::StaticOrder S; S.init(MP, D, nwg, wg); EpiRes E{P.in[0], XR, H1, SSP1};
        pg8::gemm_phase<EpiRes, pg8::StaticOrder, true, true>(lds, g, S, E);
    }
    SEAMS(5);
    for (int rep = 0; rep < REPS(6); ++rep) if (IN(6)) {
        small_gemm<1>(H1 + (size_t)MP * D, (const bf16*)(ws + WS_WUPT), FF, D, red, wg, nwg,
            [&](int row, int col, const f32x4& v) { const float r = row_rs64(SSS1, row); float a[4];
#pragma unroll
                for (int e = 0; e < 4; ++e) { const float t = fmaxf(v[e] * r, 0.f); a[e] = t * t; }
                u32x2 o; o.x = cvt_pk_bf16(a[0], a[1]); o.y = cvt_pk_bf16(a[2], a[3]); *(u32x2*)(HF + (size_t)(MP + row) * FF + col) = o; });
        pg8::Gemm g{H1, (const bf16*)(ws + WS_WUPT), MP, FF, D}; pg8::StaticOrder S; S.init(MP, FF, nwg, wg); EpiUp E{HF, SSP1};
        pg8::gemm_phase<EpiUp, pg8::StaticOrder, true, true>(lds, g, S, E);
    }
    SEAMS(6);
    if (IN(7)) {
        small_gemm<8>(HF + (size_t)MP * FF, (const bf16*)(ws + WS_WDNT), D, FF, red, wg, nwg,
            [&](int row, int col, const f32x4& v) { const size_t off = (size_t)(MP + row) * D + col; const f32x4 x = *(const f32x4*)(XR + off) + v;
                *(f32x4*)(XR + off) = x; u32x2 o; o.x = cvt_pk_bf16(x[0], x[1]); o.y = cvt_pk_bf16(x[2], x[3]); *(u32x2*)(H1 + off) = o;
                float ss = (x[0] * x[0] + x[1] * x[1]) + (x[2] * x[2] + x[3] * x[3]); ss += __shfl_xor(ss, 16); ss += __shfl_xor(ss, 32);
                if ((threadIdx.x & 63) < 16) SSS2[row * 64 + (col >> 4)] = ss; });
        pg8::Gemm g{HF, (const bf16*)(ws + WS_WDNT), MP, D, FF}; pg8::StaticOrder S; S.init(MP, D, nwg, wg); EpiRes E{XR, XR, H1, SSP2};
        pg8::gemm_phase<EpiRes, pg8::StaticOrder, true, true>(lds, g, S, E);
    }
    SEAMS(7);
    if (IN(8)) {
        small_gemm<4>(H1 + (size_t)MP * D, (const bf16*)(ws + WS_WGT), D, D, red, wg, nwg,
            [&](int row, int col, const f32x4& v) { const size_t off = (size_t)(MP + row) * D + col; const float r = row_rs64(SSS2, row);
                const u32x2 pw = *(const u32x2*)(PP + off); f32x4 x = *(const f32x4*)(XR + off);
                x[0] += sigmoidf_(v[0] * r) * bflo(pw.x); x[1] += sigmoidf_(v[1] * r) * bfhi(pw.x); x[2] += sigmoidf_(v[2] * r) * bflo(pw.y); x[3] += sigmoidf_(v[3] * r) * bfhi(pw.y);
                *(f32x4*)(XR + off) = x; });
        pg8::Gemm g{H1, (const bf16*)(ws + WS_WGT), MP, D, D}; pg8::StaticOrder S; S.init(MP, D, nwg, wg); EpiPle E{XR, PP, SSP2};
        pg8::gemm_phase<EpiPle, pg8::StaticOrder, true, true>(lds, g, S, E);
    }
    SEAMS(8);
    if (IN(9)) { phase7(P, wg, nwg); }
#undef IN
#undef SEAM
}

extern "C" void kernel_launch(void* const* d_in, const int* in_sizes, int n_in, void* d_out, int out_size, void* d_ws, size_t ws_size, hipStream_t stream) {
    static int grid = 0;
    if (grid == 0) {
        if (n_in != 22 || (size_t)out_size != OUT_END || ws_size < WS_END) { fprintf(stderr, "kernel_launch: unexpected shapes: n_in %d out %d ws %zu\n", n_in, out_size, ws_size); grid = -1; return; }
        int dev = 0, cus = 0, per_cu = 0;
        if (hipGetDevice(&dev) != hipSuccess || hipDeviceGetAttribute(&cus, hipDeviceAttributeMultiprocessorCount, dev) != hipSuccess) { grid = -1; return; }
        if (hipFuncSetAttribute((const void*)mk_fwd, hipFuncAttributeMaxDynamicSharedMemorySize, LDS_BYTES) != hipSuccess) { fprintf(stderr, "kernel_launch: hipFuncSetAttribute failed\n"); grid = -1; return; }
        if (hipOccupancyMaxActiveBlocksPerMultiprocessor(&per_cu, (const void*)mk_fwd, 512, LDS_BYTES) != hipSuccess || per_cu < 1) { fprintf(stderr, "kernel_launch: occupancy query says %d\n", per_cu); per_cu = 1; }
        (void)hipGetLastError();
        grid = cus;
    }
    if (grid < 0) return;
    if (hipMemsetAsync((char*)d_ws + WS_BAR, 0, 16384, stream) != hipSuccess) { fprintf(stderr, "kernel_launch: memset failed\n"); return; }
    Params p{};
    for (int i = 0; i < 22; ++i) p.in[i] = (const float*)d_in[i];
    p.out = (float*)d_out; p.ws = (unsigned char*)d_ws;
#if MK_PER_PHASE
    for (int ph = 0; ph < 10; ++ph) { p.ph_lo = ph; p.ph_hi = ph + 1; hipLaunchKernelGGL(mk_fwd, dim3(grid), dim3(512), LDS_BYTES, stream, p); }
#else
    p.ph_lo = 0; p.ph_hi = 10;
    void* args[] = {&p};
    hipError_t e = hipLaunchCooperativeKernel((const void*)mk_fwd, dim3(grid), dim3(512), args, LDS_BYTES, stream);
    if (e != hipSuccess) fprintf(stderr, "kernel_launch: cooperative launch failed: %s (grid %d)\n", hipGetErrorString(e), grid);
#endif
}
```
